# Optimizing an MI355X kernel written in HIP

```python
import math
import jax, jax.numpy as jnp
from jax import lax
import numpy as np

D_MODEL = 1024
BATCH = 8
SEQ = 2048
DEPTH = 2

HEAD_DIM = 64
BLK = 128
H_SB = 4
DIL_PATTERNS = ((128, 1), (512, 4), (2048, 16))
H_PER_DIL = 2
H_DIL = H_PER_DIL * len(DIL_PATTERNS)
H_SWA_Q = 6
H_SWA_KV = 2
SWA_WINDOW = 128
N_BUCKETS = 32
MAX_REL_DIST = 2048
N_SOFT_HEADS = H_DIL + H_SWA_Q
D_FF = 2816
RMS_EPS = 1e-6
ADA_CHUNKS = 9
IN_SPLITS = (H_SB * HEAD_DIM, H_SB * HEAD_DIM, H_SB * HEAD_DIM,
             H_DIL * HEAD_DIM, H_DIL * HEAD_DIM, H_DIL * HEAD_DIM,
             H_SWA_Q * HEAD_DIM, H_SWA_KV * HEAD_DIM, H_SWA_KV * HEAD_DIM,
             D_MODEL, D_MODEL, D_MODEL)
D_IN = sum(IN_SPLITS)

kernel_name = 'hybrid_sb_dilated_swa_macaron'


def rmsnorm(x, g):
    xf = x.astype(jnp.float32)
    y = xf * lax.rsqrt(jnp.mean(xf * xf, axis=-1, keepdims=True) + RMS_EPS)
    return (y * g.astype(jnp.float32)).astype(x.dtype)


def swiglu(h, wg, wu, wd):
    return (jax.nn.silu(h @ wg) * (h @ wu)) @ wd


def t5_bucket(n):
    max_exact = N_BUCKETS // 2
    nf = jnp.maximum(n, 1).astype(jnp.float32)
    large = max_exact + (jnp.log(nf / max_exact) / math.log(MAX_REL_DIST / max_exact)
                         * (N_BUCKETS - max_exact)).astype(jnp.int32)
    large = jnp.minimum(large, N_BUCKETS - 1)
    return jnp.where(n < max_exact, n, large)


def band_bias(table_cols, dilation):
    rel = jnp.arange(BLK)[:, None] + BLK - jnp.arange(2 * BLK)[None, :]
    b = t5_bucket(jnp.maximum(rel, 0) * dilation)
    return jnp.transpose(table_cols[b], (2, 0, 1)).astype(jnp.float32)


def banded_attention(q, k, v, bias, max_dist, sinks=None):
    N, L, Hk, G, Dh = q.shape
    nb = L // BLK
    qb = q.reshape(N, nb, BLK, Hk, G, Dh).astype(jnp.float32)

    def band(t):
        tb = t.reshape(N, nb, BLK, Hk, Dh).astype(jnp.float32)
        prev = jnp.pad(tb, ((0, 0), (1, 0), (0, 0), (0, 0), (0, 0)))[:, :-1]
        return jnp.concatenate([prev, tb], axis=2)

    kk, vv = band(k), band(v)
    s = jnp.einsum('nbqhgd,nbkhd->nbhgqk', qb, kk) * (Dh ** -0.5) + bias
    rel = jnp.arange(BLK)[:, None] + BLK - jnp.arange(2 * BLK)[None, :]
    in_band = (rel >= 0) & (rel <= max_dist)
    key_pos = jnp.arange(nb)[:, None] * BLK - BLK + jnp.arange(2 * BLK)[None, :]
    mask = in_band[None] & (key_pos >= 0)[:, None, :]
    s = jnp.where(mask[None, :, None, None], s, -jnp.inf)
    m = jnp.max(s, axis=-1)
    if sinks is not None:
        sk = sinks.astype(jnp.float32)[None, None, :, :, None]
        m = jnp.maximum(m, sk)
    p = jnp.exp(s - m[..., None])
    denom = jnp.sum(p, axis=-1)
    if sinks is not None:
        denom = denom + jnp.exp(sk - m)
    o = jnp.einsum('nbhgqk,nbkhd->nbqhgd', p, vv) / jnp.transpose(denom, (0, 1, 4, 2, 3))[..., None]
    lse = jnp.transpose(m + jnp.log(denom), (0, 1, 4, 2, 3))
    return o.reshape(N, L, Hk, G, Dh), lse.reshape(N, L, Hk, G)


def stick_breaking_mixer(q, k, v):
    Bn, S, H, Dh = q.shape
    nb = S // BLK
    kf, vf = k.astype(jnp.float32), v.astype(jnp.float32)
    qb = q.astype(jnp.float32).reshape(Bn, nb, BLK, H, Dh).transpose(1, 0, 2, 3, 4)
    key_pos = jnp.arange(S)

    def block(args):
        qblk, i = args
        z = jnp.einsum('bqhd,bkhd->bhqk', qblk, kf) * (Dh ** -0.5)
        q_pos = i * BLK + jnp.arange(BLK)
        before = key_pos[None, :] < q_pos[:, None]
        log_fail = jnp.where(before, jax.nn.log_sigmoid(-z), 0.0)
        between = lax.cumsum(log_fail, axis=3, reverse=True) - log_fail
        w = jnp.where(before, jnp.exp(jax.nn.log_sigmoid(z) + between), 0.0)
        return jnp.einsum('bhqk,bkhd->bqhd', w, vf)

    o = lax.map(block, (qb, jnp.arange(nb)))
    return o.transpose(1, 0, 2, 3, 4).reshape(Bn, S, H, Dh)


def dilated_mixer(q, k, v, rel_table):
    Bn, S = q.shape[:2]
    outs, lses = [], []
    for g, (w, d) in enumerate(DIL_PATTERNS):
        hs = slice(g * H_PER_DIL, (g + 1) * H_PER_DIL)
        Ls = S // d
        Lp = -(-Ls // BLK) * BLK

        def sub(t):
            t = t[:, :, hs].reshape(Bn, Ls, d, H_PER_DIL, HEAD_DIM).transpose(0, 2, 1, 3, 4)
            t = t.reshape(Bn * d, Ls, H_PER_DIL, HEAD_DIM)
            return jnp.pad(t, ((0, 0), (0, Lp - Ls), (0, 0), (0, 0)))

        bias = band_bias(rel_table[:, hs], d)[:, None]
        o, lse = banded_attention(sub(q)[:, :, :, None], sub(k), sub(v), bias, w // d)
        o = o[:, :Ls, :, 0].reshape(Bn, d, Ls, H_PER_DIL, HEAD_DIM).transpose(0, 2, 1, 3, 4)
        lse = lse[:, :Ls, :, 0].reshape(Bn, d, Ls, H_PER_DIL).transpose(0, 2, 1, 3)
        outs.append(o.reshape(Bn, S, H_PER_DIL, HEAD_DIM))
        lses.append(lse.reshape(Bn, S, H_PER_DIL))
    alpha = jax.nn.softmax(jnp.stack(lses), axis=0)
    return jnp.sum(alpha[..., None] * jnp.stack(outs), axis=0)


def swa_mixer(q, k, v, rel_table, sinks):
    Bn, S = q.shape[:2]
    G = H_SWA_Q // H_SWA_KV
    bias = band_bias(rel_table[:, H_DIL:], 1).reshape(H_SWA_KV, G, BLK, 2 * BLK)
    o, _ = banded_attention(q.reshape(Bn, S, H_SWA_KV, G, HEAD_DIM), k, v, bias,
                            SWA_WINDOW - 1, sinks.reshape(H_SWA_KV, G))
    return o.reshape(Bn, S, H_SWA_Q, HEAD_DIM)


def setup_inputs(seed: int = 0) -> dict:
    key = jax.random.key(seed)
    ks = jax.random.split(key, 18)
    f32 = jnp.float32
    nrm = lambda k, shape, scale: jax.random.normal(k, shape, f32) * scale
    return {
        'x': nrm(ks[0], (BATCH, SEQ, D_MODEL), 1.0),
        'c': nrm(ks[1], (BATCH, D_MODEL), 1.0),
        'w_ada': nrm(ks[2], (DEPTH, D_MODEL, ADA_CHUNKS * D_MODEL), 0.5 * D_MODEL ** -0.5),
        'b_ada': nrm(ks[3], (DEPTH, ADA_CHUNKS * D_MODEL), 0.02),
        'norm_gain': 1.0 + nrm(ks[4], (DEPTH, 3, D_MODEL), 0.05),
        'w_ffn_gate': nrm(ks[5], (DEPTH, 2, D_MODEL, D_FF), D_MODEL ** -0.5),
        'w_ffn_up': nrm(ks[6], (DEPTH, 2, D_MODEL, D_FF), D_MODEL ** -0.5),
        'w_ffn_down': nrm(ks[7], (DEPTH, 2, D_FF, D_MODEL), D_FF ** -0.5),
        'w_in': nrm(ks[8], (DEPTH, D_MODEL, D_IN), D_MODEL ** -0.5),
        'w_br_sb': nrm(ks[9], (DEPTH, H_SB * HEAD_DIM, D_MODEL), (H_SB * HEAD_DIM) ** -0.5),
        'w_br_dil': nrm(ks[10], (DEPTH, H_PER_DIL * HEAD_DIM, D_MODEL), (H_PER_DIL * HEAD_DIM) ** -0.5),
        'w_br_swa': nrm(ks[11], (DEPTH, H_SWA_Q * HEAD_DIM, D_MODEL), (H_SWA_Q * HEAD_DIM) ** -0.5),
        'w_out': nrm(ks[12], (DEPTH, D_MODEL, D_MODEL), D_MODEL ** -0.5),
        'sinks': nrm(ks[13], (DEPTH, H_SWA_Q), 0.5),
        'rel_bias': nrm(ks[14], (N_BUCKETS, N_SOFT_HEADS), 0.5),
        'final_gain': 1.0 + nrm(ks[15], (D_MODEL,), 0.05),
    }


def reference(x, c, w_ada, b_ada, norm_gain, w_ffn_gate, w_ffn_up, w_ffn_down, w_in,
              w_br_sb, w_br_dil, w_br_swa, w_out, sinks, rel_bias, final_gain):
    Bn, S, _ = x.shape
    split_idx = np.cumsum(IN_SPLITS)[:-1].tolist()
    heads = lambda t: t.reshape(Bn, S, -1, HEAD_DIM)
    for l in range(DEPTH):
        mod = (jax.nn.silu(c) @ w_ada[l] + b_ada[l]).reshape(Bn, 3, 3, D_MODEL)[:, :, :, None, :]

        def pre(xx, j):
            return rmsnorm(xx, norm_gain[l, j]) * (1 + mod[:, j, 1]) + mod[:, j, 0]

        h = pre(x, 0)
        x = x + 0.5 * mod[:, 0, 2] * swiglu(h, w_ffn_gate[l, 0], w_ffn_up[l, 0], w_ffn_down[l, 0])

        h = pre(x, 1)
        (q_sb, k_sb, v_sb, q_dil, k_dil, v_dil, q_swa, k_swa, v_swa,
         g_sb, g_dil, g_swa) = jnp.split(h @ w_in[l], split_idx, axis=-1)
        o_sb = stick_breaking_mixer(heads(q_sb), heads(k_sb), heads(v_sb)).reshape(Bn, S, -1).astype(x.dtype)
        o_dil = dilated_mixer(heads(q_dil), heads(k_dil), heads(v_dil), rel_bias).reshape(Bn, S, -1).astype(x.dtype)
        o_swa = swa_mixer(heads(q_swa), heads(k_swa), heads(v_swa), rel_bias, sinks[l]).reshape(Bn, S, -1).astype(x.dtype)
        merged = (jax.nn.sigmoid(g_sb) * (o_sb @ w_br_sb[l])
                  + jax.nn.sigmoid(g_dil) * (o_dil @ w_br_dil[l])
                  + jax.nn.sigmoid(g_swa) * (o_swa @ w_br_swa[l]))
        x = x + mod[:, 1, 2] * (merged @ w_out[l])

        h = pre(x, 2)
        x = x + 0.5 * mod[:, 2, 2] * swiglu(h, w_ffn_gate[l, 1], w_ffn_up[l, 1], w_ffn_down[l, 1])
    return rmsnorm(x, final_gain)
```

```cpp
#include <hip/hip_runtime.h>
#include <cstdio>
#include <cstdint>

#define LAS __attribute__((address_space(3)))
typedef unsigned short bf16;
typedef float f32x4 __attribute__((ext_vector_type(4)));
typedef unsigned u32x2 __attribute__((ext_vector_type(2)));
typedef unsigned u32x4 __attribute__((ext_vector_type(4)));

constexpr int D = 1024, BATCH = 8, SEQ = 2048, M = BATCH * SEQ, DEPTH = 2, HD = 64;
constexpr int DFF = 2816, DIN = 5632, NADA = 9216;
constexpr int C_QSB = 0, C_KSB = 256, C_VSB = 512, C_QDIL = 768, C_KDIL = 1152, C_VDIL = 1536, C_QSWA = 1920, C_KSWA = 2304, C_VSWA = 2432, C_GATE = 2560;
constexpr int OC = 768;
constexpr float RMS_EPS = 1e-6f;
constexpr float QSCALE = 0.125f * 1.4426950408889634f;
constexpr float LOG2E = 1.4426950408889634f;
constexpr int NTHREADS = 512;

constexpr size_t MiB = 1u << 20;
constexpr size_t WS_CTL = 0, WS_MOD = 1 * MiB, WS_W = 2 * MiB, WS_H = 50 * MiB, WS_OCAT = 82 * MiB, WS_BIG = 106 * MiB, WS_END = 282 * MiB;

enum { I_X = 0, I_C, I_WADA, I_BADA, I_NG, I_WG, I_WU, I_WD, I_WIN, I_WBSB, I_WBDIL, I_WBSWA, I_WOUT, I_SINKS, I_RELB, I_FG };

struct Args { const float* in[16]; float* out; unsigned char* ws; int ph_lo, ph_hi; };

__device__ __forceinline__ unsigned f2bf(float f) { unsigned u = __builtin_bit_cast(unsigned, f); return (u + 0x7fffu + ((u >> 16) & 1u)) >> 16; }
__device__ __forceinline__ float bf2f(unsigned b) { return __builtin_bit_cast(float, b << 16); }
__device__ __forceinline__ unsigned pk2(float lo, float hi) { return f2bf(lo) | (f2bf(hi) << 16); }
__device__ __forceinline__ float wave_sum(float v) {
#pragma unroll
    for (int o = 1; o < 64; o <<= 1) v += __shfl_xor(v, o);
    return v;
}
__device__ __forceinline__ float sigmoidf_(float x) { return 1.0f / (1.0f + __expf(-x)); }

struct Frame {
    LAS unsigned char* lds;
    int tid, lane, wave, G, wg;
    const float* in[16];
    float* X;
    float* mod;
    bf16 *H, *OCAT, *QKVG, *ACT;
    unsigned char* ws;
};

__device__ __forceinline__ const float* modp(const Frame& F, int l, int b, int j, int t) { return F.mod + ((size_t)(l * BATCH + b) * NADA) + (j * 3 + t) * D; }

__device__ __forceinline__ void ph_adaln_naive(Frame& F) {
    const float* c = F.in[I_C]; const float* w = F.in[I_WADA]; const float* bb = F.in[I_BADA];
    for (int idx = F.wg * NTHREADS + F.tid; idx < DEPTH * BATCH * NADA; idx += F.G * NTHREADS) {
        const int n = idx % NADA, b = (idx / NADA) % BATCH, l = idx / (NADA * BATCH);
        const float* wl = w + (size_t)l * D * NADA + n; const float* cb = c + b * D;
        float s = 0.f;
        for (int k = 0; k < D; ++k) { const float cv = cb[k]; s += (cv * sigmoidf_(cv)) * wl[(size_t)k * NADA]; }
        F.mod[idx] = s + bb[l * NADA + n];
    }
}

__device__ __forceinline__ void ph_prep(Frame& F, const float* xin, int l, int j) {
    const float* g = F.in[I_NG] + (l * 3 + j) * D;
    const int gw = F.wg * (NTHREADS / 64) + F.wave, NGW = F.G * (NTHREADS / 64);
    for (int m = gw; m < M; m += NGW) {
        const int b = m / SEQ; const float* sh = modp(F, l, b, j, 0); const float* sc = modp(F, l, b, j, 1);
        const f32x4* xr = (const f32x4*)(xin + (size_t)m * D) + F.lane;
        f32x4 v[4]; float s = 0.f;
#pragma unroll
        for (int i = 0; i < 4; ++i) { v[i] = xr[64 * i]; s += (v[i].x * v[i].x + v[i].y * v[i].y) + (v[i].z * v[i].z + v[i].w * v[i].w); }
        const float rstd = 1.0f / sqrtf(wave_sum(s) * (1.f / D) + RMS_EPS);
        u32x2* o = (u32x2*)(F.H + (size_t)m * D) + F.lane;
#pragma unroll
        for (int i = 0; i < 4; ++i) {
            const int c0 = 4 * F.lane + 256 * i; const f32x4 gg = *(const f32x4*)(g + c0), ss = *(const f32x4*)(sc + c0), hh = *(const f32x4*)(sh + c0);
            f32x4 y; y = v[i] * rstd * gg * (1.0f + ss) + hh;
            u32x2 w; w.x = pk2(y.x, y.y); w.y = pk2(y.z, y.w); o[64 * i] = w;
        }
    }
}
__device__ __forceinline__ void ph_final(Frame& F) {
    const float* g = F.in[I_FG];
    const int gw = F.wg * (NTHREADS / 64) + F.wave, NGW = F.G * (NTHREADS / 64);
    for (int m = gw; m < M; m += NGW) {
        f32x4* xr = (f32x4*)(F.X + (size_t)m * D) + F.lane;
        f32x4 v[4]; float s = 0.f;
#pragma unroll
        for (int i = 0; i < 4; ++i) { v[i] = xr[64 * i]; s += (v[i].x * v[i].x + v[i].y * v[i].y) + (v[i].z * v[i].z + v[i].w * v[i].w); }
        const float rstd = 1.0f / sqrtf(wave_sum(s) * (1.f / D) + RMS_EPS);
#pragma unroll
        for (int i = 0; i < 4; ++i) { const f32x4 gg = *(const f32x4*)(g + 4 * F.lane + 256 * i); xr[64 * i] = v[i] * rstd * gg; }
    }
}

constexpr int NG_BK = 16, NG_AS = 132;
__device__ __forceinline__ void ngemm_tile(float (&acc)[4][8], const bf16* A, int lda, const float* W, int ldw, int K, int m0, int n0, LAS float* As, LAS float* Bs, int tid) {
    const int ty = tid >> 4, tx = tid & 15;
    const int arow = tid >> 2, akq = (tid & 3) * 4, bk = tid >> 5, bn = (tid & 31) * 4;
    for (int k0 = 0; k0 < K; k0 += NG_BK) {
        const u32x2 av = *(const u32x2*)(A + (size_t)(m0 + arow) * lda + k0 + akq);
        const f32x4 bv = *(const f32x4*)(W + (size_t)(k0 + bk) * ldw + n0 + bn);
        __syncthreads();
        As[(akq + 0) * NG_AS + arow] = bf2f(av.x & 0xffffu); As[(akq + 1) * NG_AS + arow] = bf2f(av.x >> 16);
        As[(akq + 2) * NG_AS + arow] = bf2f(av.y & 0xffffu); As[(akq + 3) * NG_AS + arow] = bf2f(av.y >> 16);
        *(LAS f32x4*)(Bs + bk * 128 + bn) = bv;
        __syncthreads();
#pragma unroll
        for (int kk = 0; kk < NG_BK; ++kk) {
            const f32x4 a = *(const LAS f32x4*)(As + kk * NG_AS + ty * 4);
            const f32x4 b0 = *(const LAS f32x4*)(Bs + kk * 128 + tx * 8), b1 = *(const LAS f32x4*)(Bs + kk * 128 + tx * 8 + 4);
            const float av4[4] = {a.x, a.y, a.z, a.w}; const float bv8[8] = {b0.x, b0.y, b0.z, b0.w, b1.x, b1.y, b1.z, b1.w};
#pragma unroll
            for (int i = 0; i < 4; ++i)
#pragma unroll
                for (int j = 0; j < 8; ++j) acc[i][j] += av4[i] * bv8[j];
        }
    }
}
#define NG_ZERO(acc) _Pragma("unroll") for (int i_ = 0; i_ < 4; ++i_) _Pragma("unroll") for (int j_ = 0; j_ < 8; ++j_) acc[i_][j_] = 0.f

__device__ __forceinline__ void ph_ffn_up_naive(Frame& F, int l, int f) {
    LAS float* As = (LAS float*)F.lds; LAS float* Bs = As + NG_BK * NG_AS;
    const float* Wg = F.in[I_WG] + (size_t)(l * 2 + f) * D * DFF; const float* Wu = F.in[I_WU] + (size_t)(l * 2 + f) * D * DFF;
    const int ty = F.tid >> 4, tx = F.tid & 15;
    for (int t = F.wg; t < (M / 128) * (DFF / 128); t += F.G) {
        const int m0 = (t / (DFF / 128)) * 128, n0 = (t % (DFF / 128)) * 128;
        float ag[4][8], au[4][8]; NG_ZERO(ag); NG_ZERO(au);
        ngemm_tile(ag, F.H, D, Wg, DFF, D, m0, n0, As, Bs, F.tid);
        ngemm_tile(au, F.H, D, Wu, DFF, D, m0, n0, As, Bs, F.tid);
#pragma unroll
        for (int i = 0; i < 4; ++i) {
            u32x4 w; unsigned p[4];
#pragma unroll
            for (int j = 0; j < 4; ++j) { const float g0 = ag[i][2 * j], g1 = ag[i][2 * j + 1]; p[j] = pk2(g0 * sigmoidf_(g0) * au[i][2 * j], g1 * sigmoidf_(g1) * au[i][2 * j + 1]); }
            w.x = p[0]; w.y = p[1]; w.z = p[2]; w.w = p[3];
            *(u32x4*)(F.ACT + (size_t)(m0 + ty * 4 + i) * DFF + n0 + tx * 8) = w;
        }
    }
}
__device__ __forceinline__ void ph_xupd_naive(Frame& F, const bf16* A, int K, const float* W, const float* xin, float* xout, int l, int j, float cs) {
    LAS float* As = (LAS float*)F.lds; LAS float* Bs = As + NG_BK * NG_AS;
    const int ty = F.tid >> 4, tx = F.tid & 15;
    for (int t = F.wg; t < (M / 128) * (D / 128); t += F.G) {
        const int m0 = (t / (D / 128)) * 128, n0 = (t % (D / 128)) * 128;
        float acc[4][8]; NG_ZERO(acc);
        ngemm_tile(acc, A, K, W, D, K, m0, n0, As, Bs, F.tid);
        const float* coef = modp(F, l, m0 / SEQ, j, 2) + n0 + tx * 8;
#pragma unroll
        for (int i = 0; i < 4; ++i) {
            const size_t off = (size_t)(m0 + ty * 4 + i) * D + n0 + tx * 8;
#pragma unroll
            for (int j4 = 0; j4 < 2; ++j4) {
                const f32x4 xv = *(const f32x4*)(xin + off + 4 * j4), cv = *(const f32x4*)(coef + 4 * j4);
                f32x4 a; a.x = acc[i][4 * j4]; a.y = acc[i][4 * j4 + 1]; a.z = acc[i][4 * j4 + 2]; a.w = acc[i][4 * j4 + 3];
                *(f32x4*)(xout + off + 4 * j4) = xv + cs * cv * a;
            }
        }
    }
}
__device__ __forceinline__ void ph_inproj_naive(Frame& F, int l) {
    LAS float* As = (LAS float*)F.lds; LAS float* Bs = As + NG_BK * NG_AS;
    const float* W = F.in[I_WIN] + (size_t)l * D * DIN;
    const int ty = F.tid >> 4, tx = F.tid & 15;
    for (int t = F.wg; t < (M / 128) * (DIN / 128); t += F.G) {
        const int m0 = (t / (DIN / 128)) * 128, n0 = (t % (DIN / 128)) * 128;
        float acc[4][8]; NG_ZERO(acc);
        ngemm_tile(acc, F.H, D, W, DIN, D, m0, n0, As, Bs, F.tid);
        const bool isq = (n0 < C_KSB) || (n0 >= C_QDIL && n0 < C_KDIL) || (n0 >= C_QSWA && n0 < C_KSWA), isg = n0 >= C_GATE;
#pragma unroll
        for (int i = 0; i < 4; ++i) {
            unsigned p[4];
#pragma unroll
            for (int j = 0; j < 4; ++j) { float a = acc[i][2 * j], b = acc[i][2 * j + 1]; if (isq) { a *= QSCALE; b *= QSCALE; } if (isg) { a = sigmoidf_(a); b = sigmoidf_(b); } p[j] = pk2(a, b); }
            u32x4 w; w.x = p[0]; w.y = p[1]; w.z = p[2]; w.w = p[3];
            *(u32x4*)(F.QKVG + (size_t)(m0 + ty * 4 + i) * DIN + n0 + tx * 8) = w;
        }
    }
}
__device__ __forceinline__ void ph_branch_naive(Frame& F, int l) {
    LAS float* As = (LAS float*)F.lds; LAS float* Bs = As + NG_BK * NG_AS;
    const float* W0 = F.in[I_WBSB] + (size_t)l * 256 * D; const float* W1 = F.in[I_WBDIL] + (size_t)l * 128 * D; const float* W2 = F.in[I_WBSWA] + (size_t)l * 384 * D;
    const int ty = F.tid >> 4, tx = F.tid & 15;
    for (int t = F.wg; t < (M / 128) * (D / 128); t += F.G) {
        const int m0 = (t / (D / 128)) * 128, n0 = (t % (D / 128)) * 128;
        float tot[4][8]; NG_ZERO(tot);
#pragma unroll 1
        for (int br = 0; br < 3; ++br) {
            float acc[4][8]; NG_ZERO(acc);
            const int ko = br == 0 ? 0 : (br == 1 ? 256 : 384), Kb = br == 0 ? 256 : (br == 1 ? 128 : 384);
            ngemm_tile(acc, F.OCAT + ko, OC, br == 0 ? W0 : (br == 1 ? W1 : W2), D, Kb, m0, n0, As, Bs, F.tid);
#pragma unroll
            for (int i = 0; i < 4; ++i) {
                const u32x4 gv = *(const u32x4*)(F.QKVG + (size_t)(m0 + ty * 4 + i) * DIN + C_GATE + br * D + n0 + tx * 8);
                const unsigned gw[4] = {gv.x, gv.y, gv.z, gv.w};
#pragma unroll
                for (int j = 0; j < 4; ++j) { tot[i][2 * j] += bf2f(gw[j] & 0xffffu) * acc[i][2 * j]; tot[i][2 * j + 1] += bf2f(gw[j] >> 16) * acc[i][2 * j + 1]; }
            }
        }
#pragma unroll
        for (int i = 0; i < 4; ++i) {
            u32x4 w; w.x = pk2(tot[i][0], tot[i][1]); w.y = pk2(tot[i][2], tot[i][3]); w.z = pk2(tot[i][4], tot[i][5]); w.w = pk2(tot[i][6], tot[i][7]);
            *(u32x4*)(F.H + (size_t)(m0 + ty * 4 + i) * D + n0 + tx * 8) = w;
        }
    }
}

__device__ __forceinline__ int t5_bucket(int n) {
    if (n < 16) return n;
    int b = 16;
    b += (n >= 22); b += (n >= 30); b += (n >= 40); b += (n >= 54); b += (n >= 73); b += (n >= 99); b += (n >= 134); b += (n >= 182);
    b += (n >= 246); b += (n >= 332); b += (n >= 450); b += (n >= 609); b += (n >= 825); b += (n >= 1117); b += (n >= 1513); b += (n >= 2048);
    return b > 31 ? 31 : b;
}
__device__ __forceinline__ void load_row64(float (&r)[64], const bf16* p) {
#pragma unroll
    for (int c = 0; c < 8; ++c) { const u32x4 v = *(const u32x4*)(p + 8 * c); const unsigned w[4] = {v.x, v.y, v.z, v.w};
#pragma unroll
        for (int j = 0; j < 4; ++j) { r[8 * c + 2 * j] = bf2f(w[j] & 0xffffu); r[8 * c + 2 * j + 1] = bf2f(w[j] >> 16); } }
}
__device__ __forceinline__ void store_row32(bf16* p, const float (&r)[32], float s) {
#pragma unroll
    for (int c = 0; c < 4; ++c) { u32x4 w; w.x = pk2(r[8 * c] * s, r[8 * c + 1] * s); w.y = pk2(r[8 * c + 2] * s, r[8 * c + 3] * s); w.z = pk2(r[8 * c + 4] * s, r[8 * c + 5] * s); w.w = pk2(r[8 * c + 6] * s, r[8 * c + 7] * s); *(u32x4*)(p + 8 * c) = w; }
}
__device__ __forceinline__ float dot_row64(const float (&q)[64], const bf16* p) {
    float s0 = 0.f, s1 = 0.f;
#pragma unroll
    for (int c = 0; c < 8; ++c) { const u32x4 v = *(const u32x4*)(p + 8 * c); const unsigned w[4] = {v.x, v.y, v.z, v.w};
#pragma unroll
        for (int j = 0; j < 4; ++j) { s0 += q[8 * c + 2 * j] * bf2f(w[j] & 0xffffu); s1 += q[8 * c + 2 * j + 1] * bf2f(w[j] >> 16); } }
    return s0 + s1;
}
__device__ __forceinline__ void axpy_row32(float (&o)[32], float a, const bf16* p) {
#pragma unroll
    for (int c = 0; c < 4; ++c) { const u32x4 v = *(const u32x4*)(p + 8 * c); const unsigned w[4] = {v.x, v.y, v.z, v.w};
#pragma unroll
        for (int j = 0; j < 4; ++j) { o[8 * c + 2 * j] += a * bf2f(w[j] & 0xffffu); o[8 * c + 2 * j + 1] += a * bf2f(w[j] >> 16); } }
}
__device__ __forceinline__ void ph_sb_naive(Frame& F) {
    const int gw = F.wg * (NTHREADS / 64) + F.wave, NGW = F.G * (NTHREADS / 64);
    for (int it = gw; it < BATCH * 4 * (SEQ / 64) * 2; it += NGW) {
        const int dh = it & 1, tb = (it >> 1) % (SEQ / 64), h = ((it >> 1) / (SEQ / 64)) % 4, b = (it >> 1) / ((SEQ / 64) * 4);
        const int t = tb * 64 + F.lane; const size_t rowb = (size_t)b * SEQ;
        float q[64], o[32]; load_row64(q, F.QKVG + (rowb + t) * DIN + C_QSB + h * HD);
#pragma unroll
        for (int d = 0; d < 32; ++d) o[d] = 0.f;
        float c = 0.f;
        for (int s = tb * 64 + 62; s >= 0; --s) {
            const bf16* kr = F.QKVG + (rowb + s) * DIN + C_KSB + h * HD;
            const float z = dot_row64(q, kr);
            if (s < t) {
                const float sp = fmaxf(z, 0.f) + log2f(1.0f + exp2f(-fabsf(z)));
                c += sp;
                axpy_row32(o, exp2f(z - c), kr + (C_VSB - C_KSB) + dh * 32);
            }
        }
        store_row32(F.OCAT + (rowb + t) * OC + h * HD + dh * 32, o, 1.0f);
    }
}
__device__ __forceinline__ void ph_dil_naive(Frame& F) {
    const float* relb = F.in[I_RELB];
    for (int idx = F.wg * NTHREADS + F.tid; idx < M * 4; idx += F.G * NTHREADS) {
        const int dh = idx / (2 * M), slot = (idx / M) & 1, m = idx % M, b = m / SEQ, t = m % SEQ; const size_t rowb = (size_t)b * SEQ;
        float o[32];
#pragma unroll
        for (int d = 0; d < 32; ++d) o[d] = 0.f;
        float mx = -INFINITY, l = 0.f;
#pragma unroll 1
        for (int g = 0; g < 3; ++g) {
            const int dil = g == 0 ? 1 : (g == 1 ? 4 : 16), head = 2 * g + slot;
            float q[64]; load_row64(q, F.QKVG + (rowb + t) * DIN + C_QDIL + head * HD);
#pragma unroll 1
            for (int dd = 0; dd <= 128; ++dd) {
                const int s = t - dd * dil; if (s < 0) break;
                const bf16* kr = F.QKVG + (rowb + s) * DIN + C_KDIL + head * HD;
                const float sc = dot_row64(q, kr) + relb[t5_bucket(dd * dil) * 12 + head] * LOG2E;
                const float mn = fmaxf(mx, sc), f = exp2f(mx - mn), p = exp2f(sc - mn);
#pragma unroll
                for (int d = 0; d < 32; ++d) o[d] *= f;
                l = l * f + p; mx = mn;
                axpy_row32(o, p, kr + (C_VDIL - C_KDIL) + dh * 32);
            }
        }
        store_row32(F.OCAT + (rowb + t) * OC + 256 + slot * HD + dh * 32, o, 1.0f / l);
    }
}
__device__ __forceinline__ void ph_swa_naive(Frame& F, int l) {
    const float* relb = F.in[I_RELB]; const float* sinks = F.in[I_SINKS] + l * 6;
    for (int idx = F.wg * NTHREADS + F.tid; idx < M * 12; idx += F.G * NTHREADS) {
        const int dh = idx / (6 * M), hq = (idx / M) % 6, m = idx % M, b = m / SEQ, t = m % SEQ, kv = hq / 3; const size_t rowb = (size_t)b * SEQ;
        float o[32], q[64];
#pragma unroll
        for (int d = 0; d < 32; ++d) o[d] = 0.f;
        load_row64(q, F.QKVG + (rowb + t) * DIN + C_QSWA + hq * HD);
        const float sk = sinks[hq] * LOG2E;
        float mx = sk, lsum = 1.0f;
#pragma unroll 1
        for (int dd = 0; dd <= 127; ++dd) {
            const int s = t - dd; if (s < 0) break;
            const bf16* kr = F.QKVG + (rowb + s) * DIN + C_KSWA + kv * HD;
            const float sc = dot_row64(q, kr) + relb[t5_bucket(dd) * 12 + 6 + hq] * LOG2E;
            const float mn = fmaxf(mx, sc), f = exp2f(mx - mn), p = exp2f(sc - mn);
#pragma unroll
            for (int d = 0; d < 32; ++d) o[d] *= f;
            lsum = lsum * f + p; mx = mn;
            axpy_row32(o, p, kr + (C_VSWA - C_KSWA) + dh * 32);
        }
        store_row32(F.OCAT + (rowb + t) * OC + 384 + hq * HD + dh * 32, o, 1.0f / lsum);
    }
}

constexpr size_t WO_GU0 = 0, WO_D0 = 11 * MiB, WO_GU1 = 16 * MiB + MiB / 2, WO_D1 = 27 * MiB + MiB / 2, WO_IN = 33 * MiB, WO_BR = 44 * MiB, WO_OUT = 45 * MiB + MiB / 2;
static_assert(WS_W + WO_OUT + 2 * MiB <= WS_H, "weight copies fit below H");
__host__ __device__ __forceinline__ int perm32(int rho) { const int n = rho >> 4, i = rho & 15; return 8 * (i >> 2) + 4 * n + (i & 3); }

__device__ __forceinline__ void cv_item(const float* src, int Nsrc, int srccol, bf16* dst, int Kd, int prow0, int ks0, int kd0, LAS float* scr, int lane) {
#pragma unroll 8
    for (int i = 0; i < 32; ++i) { const int kk = 2 * i + (lane >> 5); scr[kk * 33 + (lane & 31)] = src[(size_t)(ks0 + kk) * Nsrc + srccol]; }
    asm volatile("s_waitcnt lgkmcnt(0)" ::: "memory");
    const int c = lane & 7;
#pragma unroll
    for (int j = 0; j < 4; ++j) { const int n = (lane >> 3) + 8 * j; const LAS float* sp = scr + (8 * c) * 33 + n;
        u32x4 o; o.x = pk2(sp[0 * 33], sp[1 * 33]); o.y = pk2(sp[2 * 33], sp[3 * 33]); o.z = pk2(sp[4 * 33], sp[5 * 33]); o.w = pk2(sp[6 * 33], sp[7 * 33]);
        *(u32x4*)(dst + (size_t)(prow0 + n) * Kd + kd0 + 8 * c) = o; }
    asm volatile("s_waitcnt lgkmcnt(0)" ::: "memory");
}
__device__ __forceinline__ void ph_convert(Frame& F, int l) {
    LAS float* scr = (LAS float*)(F.lds + F.wave * 16384);
    const int gw = F.wg * (NTHREADS / 64) + F.wave, NGW = F.G * (NTHREADS / 64);
    unsigned char* wb = F.ws + WS_W;
    constexpr int I_GU = 16 * 176, I_D = 44 * 32, I_IN = 16 * 176, I_B0 = 4 * 32, I_B1 = 2 * 32, I_B2 = 6 * 32, I_O = 16 * 32;
    constexpr int NIT = 2 * I_GU + 2 * I_D + I_IN + I_B0 + I_B1 + I_B2 + I_O;
    const int r = F.lane & 31;
    for (int it = gw; it < NIT; it += NGW) {
        int x = it;
        if (x < 2 * I_GU) { const int f = x / I_GU; x %= I_GU; const int kb = x / 176, nb = x % 176, p0 = nb * 32, t = p0 >> 8, bj = (p0 >> 7) & 1, wc = (p0 >> 5) & 3;
            const float* src = F.in[bj ? I_WU : I_WG] + (size_t)(l * 2 + f) * D * DFF;
            cv_item(src, DFF, 128 * t + 32 * wc + perm32(r), (bf16*)(wb + (f ? WO_GU1 : WO_GU0)), D, p0, kb * 64, kb * 64, scr, F.lane); continue; }
        x -= 2 * I_GU;
        if (x < 2 * I_D) { const int f = x / I_D; x %= I_D; const int kb = x / 32, nb = x % 32;
            cv_item(F.in[I_WD] + (size_t)(l * 2 + f) * DFF * D, D, nb * 32 + r, (bf16*)(wb + (f ? WO_D1 : WO_D0)), DFF, nb * 32, kb * 64, kb * 64, scr, F.lane); continue; }
        x -= 2 * I_D;
        if (x < I_IN) { const int kb = x / 176, nb = x % 176;
            cv_item(F.in[I_WIN] + (size_t)l * D * DIN, DIN, nb * 32 + perm32(r), (bf16*)(wb + WO_IN), D, nb * 32, kb * 64, kb * 64, scr, F.lane); continue; }
        x -= I_IN;
        if (x < I_B0) { const int kb = x / 32, nb = x % 32;
            cv_item(F.in[I_WBSB] + (size_t)l * 256 * D, D, nb * 32 + perm32(r), (bf16*)(wb + WO_BR), OC, nb * 32, kb * 64, kb * 64, scr, F.lane); continue; }
        x -= I_B0;
        if (x < I_B1) { const int kb = x / 32, nb = x % 32;
            cv_item(F.in[I_WBDIL] + (size_t)l * 128 * D, D, nb * 32 + perm32(r), (bf16*)(wb + WO_BR), OC, nb * 32, kb * 64, 256 + kb * 64, scr, F.lane); continue; }
        x -= I_B1;
        if (x < I_B2) { const int kb = x / 32, nb = x % 32;
            cv_item(F.in[I_WBSWA] + (size_t)l * 384 * D, D, nb * 32 + perm32(r), (bf16*)(wb + WO_BR), OC, nb * 32, kb * 64, 384 + kb * 64, scr, F.lane); continue; }
        x -= I_B2;
        { const int kb = x / 32, nb = x % 32;
            cv_item(F.in[I_WOUT] + (size_t)l * D * D, D, nb * 32 + r, (bf16*)(wb + WO_OUT), D, nb * 32, kb * 64, kb * 64, scr, F.lane); }
    }
}

namespace pg8 {
typedef short bf16x8 __attribute__((ext_vector_type(8)));
constexpr int BM = 256, BK = 64, HALF = 128, HTB = HALF * BK * 2, STAGE_BYTES = 8 * HTB, NXCD = 8, WGM = 8;
__host__ __device__ __forceinline__ int lds_byte(int r, int c) { const int st = (r >> 4) * 2 + (c >> 5), rr = r & 15, cc = c & 31, ob = rr * 64 + cc * 2; return st * 1024 + (ob ^ (((ob >> 9) & 1) << 5)); }
__host__ __device__ __forceinline__ void stage_rc(int b, int& R, int& C) { const int st = b / 1024, sb = b % 1024, swz = sb ^ (((sb >> 9) & 1) << 5); R = (st >> 1) * 16 + swz / 64; C = (st & 1) * 32 + (swz % 64) / 2; }
struct Unit { int pm, pn, br; };
struct Gemm { const bf16* A; const bf16* Bt; int ld; };
template <int NBR> struct StaticOrderT {
    int nM, nN, nwg, G, c;
    __device__ void init(int M_, int N_, int G_, int c_) { nM = M_ / BM; nN = N_ / BM; nwg = nM * nN; G = G_; c = c_; }
    __device__ bool next(int i, Unit& u) const {
        const long L = (long)(i / NBR) * G + c; if (L >= nwg) return false;
        int wgid = (int)L; { const int q = nwg / NXCD, r = nwg % NXCD, xcd = wgid % NXCD, off = wgid / NXCD; wgid = (xcd < r ? xcd * (q + 1) : r * (q + 1) + (xcd - r) * q) + off; }
        const int nig = WGM * nN, gid = wgid / nig, fm = gid * WGM, gsz = (nM - fm) < WGM ? (nM - fm) : WGM;
        u.pm = fm + ((wgid % nig) % gsz); u.pn = (wgid % nig) / gsz; u.br = i % NBR; return true;
    }
};
struct OrderK : StaticOrderT<1> {
    int ntiles;
    __device__ __forceinline__ int nt(const Unit&) const { return ntiles; }
    __device__ __forceinline__ int kofs(const Unit&) const { return 0; }
};
struct OrderBr : StaticOrderT<3> {
    __device__ __forceinline__ int nt(const Unit& u) const { return u.br == 0 ? 4 : (u.br == 1 ? 2 : 6); }
    __device__ __forceinline__ int kofs(const Unit& u) const { return u.br == 0 ? 0 : (u.br == 1 ? 256 : 384); }
};

template <class Epi, class Sched, bool ALIGN_EPI, bool SP2>
__device__ __forceinline__ void gemm_phase(LAS unsigned char* lds, const Gemm g, const Sched& S, const Epi& E) {
    const int tid = threadIdx.x, wid = __builtin_amdgcn_readfirstlane(tid >> 6), lane = tid & 63, wr = wid >> 2, wc = wid & 3, fr = lane & 15, fq = lane >> 4;
    const int LD = g.ld;
    unsigned voff[2];
#pragma unroll
    for (int i = 0; i < 2; ++i) { int R, C; stage_rc(tid * 16 + i * 8192, R, C); voff[i] = (unsigned)(R * LD + C) * 2u; }
    const size_t kstep = (size_t)(BK * 2);
    const size_t hstep = (size_t)HALF * LD * 2;
    const size_t tstep = 2 * hstep;
    const unsigned ldsw = (unsigned)wid * 1024u;
    const int aoff = lds_byte(wr * 64 + fr, fq * 8), boff = lds_byte(wc * 32 + fr, fq * 8);
#define PG8_SA(b, h) (((b) * 2 + (h)) * HTB)
#define PG8_SB(b, h) ((4 + (b) * 2 + (h)) * HTB)
#define PG8_STAGE(bufoff, gbase) do { _Pragma("unroll") for (int _i = 0; _i < 2; ++_i) \
        __builtin_amdgcn_global_load_lds((const unsigned*)((const char*)(gbase) + voff[_i]), (LAS unsigned*)(lds + (bufoff) + ldsw + _i * 8192), 16, 0, 0); } while (0)
#define PG8_LDA(dst, b, h) do { _Pragma("unroll") for (int m = 0; m < 4; ++m) _Pragma("unroll") for (int k = 0; k < 2; ++k) dst[m][k] = *(const LAS bf16x8*)(lds + PG8_SA(b, h) + aoff + m * 2048 + k * 1024); } while (0)
#define PG8_LDB(dst, b, h) do { _Pragma("unroll") for (int n = 0; n < 2; ++n) _Pragma("unroll") for (int k = 0; k < 2; ++k) dst[n][k] = *(const LAS bf16x8*)(lds + PG8_SB(b, h) + boff + n * 2048 + k * 1024); } while (0)
#define PG8_MMA(ai, bj, At, Bt) do { __builtin_amdgcn_s_setprio(1); _Pragma("unroll") for (int m = 0; m < 4; ++m) _Pragma("unroll") for (int n = 0; n < 2; ++n) _Pragma("unroll") for (int k = 0; k < 2; ++k) \
        acc[ai][bj][m][n] = __builtin_amdgcn_mfma_f32_16x16x32_bf16(Bt[n][k], At[m][k], acc[ai][bj][m][n], 0, 0, 0); __builtin_amdgcn_s_setprio(0); } while (0)
#define PG8_WAIT_V(n) asm volatile("s_waitcnt vmcnt(" #n ")" ::: "memory")
#define PG8_WAIT_L(n) asm volatile("s_waitcnt lgkmcnt(" #n ")" ::: "memory")
#define PG8_BAR __builtin_amdgcn_s_barrier()
#define PG8_SCHED __builtin_amdgcn_sched_barrier(0)
#define PG8_ZERO() do { _Pragma("unroll") for (int a_ = 0; a_ < 2; ++a_) _Pragma("unroll") for (int b_ = 0; b_ < 2; ++b_) _Pragma("unroll") for (int m_ = 0; m_ < 4; ++m_) _Pragma("unroll") for (int n_ = 0; n_ < 2; ++n_) acc[a_][b_][m_][n_] = (f32x4){0.f, 0.f, 0.f, 0.f}; } while (0)
    Unit cur, nxt; int ui = 0;
    if (!S.next(0, cur)) return;
    f32x4 acc[2][2][4][2];
    PG8_ZERO();
    bf16x8 At[4][2], B0[2][2], B1[2][2];
    const char* cA = (const char*)g.A + (size_t)cur.pm * tstep + (size_t)S.kofs(cur) * 2; const char* cB = (const char*)g.Bt + (size_t)cur.pn * tstep + (size_t)S.kofs(cur) * 2;
    if constexpr (SP2) {
        PG8_STAGE(PG8_SB(0, 0), cB); PG8_STAGE(PG8_SB(0, 1), cB + hstep); PG8_STAGE(PG8_SA(0, 0), cA); PG8_STAGE(PG8_SA(0, 1), cA + hstep);
        if (wr == 1) PG8_BAR;
        PG8_WAIT_V(2); PG8_BAR;
        PG8_STAGE(PG8_SB(1, 0), cB + kstep); PG8_STAGE(PG8_SA(1, 0), cA + kstep); PG8_STAGE(PG8_SB(1, 1), cB + hstep + kstep);
        PG8_WAIT_V(6); PG8_BAR;
    } else {
        PG8_STAGE(PG8_SB(0, 0), cB); PG8_STAGE(PG8_SA(0, 0), cA); PG8_STAGE(PG8_SB(0, 1), cB + hstep); PG8_STAGE(PG8_SA(0, 1), cA + hstep);
        if (wr == 1) PG8_BAR;
        PG8_WAIT_V(4); PG8_BAR;
        PG8_STAGE(PG8_SB(1, 0), cB + kstep); PG8_STAGE(PG8_SA(1, 0), cA + kstep); PG8_STAGE(PG8_SB(1, 1), cB + hstep + kstep);
        PG8_WAIT_V(6); PG8_BAR;
    }
    for (;;) {
        const bool has_next = S.next(ui + 1, nxt);
        const char* nA = has_next ? (const char*)g.A + (size_t)nxt.pm * tstep + (size_t)S.kofs(nxt) * 2 : cA; const char* nB = has_next ? (const char*)g.Bt + (size_t)nxt.pn * tstep + (size_t)S.kofs(nxt) * 2 : cB;
        const int nt = S.nt(cur);
        for (int t = 0; t < nt; t += 2) {
            const bool last = (t == nt - 2);
            const char* a1 = cA + (size_t)(t + 1) * kstep;
            const char* a2 = last ? nA : cA + (size_t)(t + 2) * kstep; const char* b2 = last ? nB : cB + (size_t)(t + 2) * kstep;
            const char* a3 = a2 + kstep; const char* b3 = b2 + kstep;
            if constexpr (SP2) {
            PG8_LDB(B0, 0, 0); PG8_LDB(B1, 0, 1); PG8_SCHED; PG8_LDA(At, 0, 0); PG8_STAGE(PG8_SA(1, 1), a1 + hstep);
            PG8_WAIT_V(8); PG8_WAIT_L(0); PG8_BAR; PG8_MMA(0, 0, At, B0); PG8_MMA(0, 1, At, B1); PG8_BAR; PG8_SCHED;
            PG8_LDA(At, 0, 1); PG8_STAGE(PG8_SB(0, 0), b2); PG8_STAGE(PG8_SB(0, 1), b2 + hstep); PG8_STAGE(PG8_SA(0, 0), a2);
            PG8_WAIT_V(8); PG8_WAIT_L(0); PG8_BAR; PG8_MMA(1, 0, At, B0); PG8_MMA(1, 1, At, B1); PG8_BAR; PG8_SCHED;
            PG8_LDB(B0, 1, 0); PG8_LDB(B1, 1, 1); PG8_SCHED; PG8_LDA(At, 1, 0); PG8_STAGE(PG8_SA(0, 1), a2 + hstep);
            PG8_WAIT_V(8); PG8_WAIT_L(0); PG8_BAR; PG8_MMA(0, 0, At, B0); PG8_MMA(0, 1, At, B1); PG8_BAR; PG8_SCHED;
            PG8_LDA(At, 1, 1); PG8_STAGE(PG8_SB(1, 0), b3); PG8_STAGE(PG8_SB(1, 1), b3 + hstep); PG8_STAGE(PG8_SA(1, 0), a3);
            PG8_WAIT_V(8); PG8_WAIT_L(0); PG8_BAR; PG8_MMA(1, 0, At, B0); PG8_MMA(1, 1, At, B1); PG8_BAR; PG8_SCHED;
            } else {
            PG8_LDB(B0, 0, 0); PG8_SCHED; PG8_LDA(At, 0, 0); PG8_STAGE(PG8_SA(1, 1), a1 + hstep);
            PG8_WAIT_L(8); PG8_BAR; PG8_WAIT_L(0); PG8_MMA(0, 0, At, B0); PG8_BAR; PG8_SCHED;
            PG8_LDB(B1, 0, 1); PG8_STAGE(PG8_SB(0, 0), b2);
            PG8_BAR; PG8_WAIT_L(0); PG8_MMA(0, 1, At, B1); PG8_BAR;
            PG8_LDA(At, 0, 1); PG8_STAGE(PG8_SA(0, 0), a2);
            PG8_BAR; PG8_WAIT_L(0); PG8_MMA(1, 0, At, B0); PG8_BAR; PG8_SCHED;
            PG8_STAGE(PG8_SB(0, 1), b2 + hstep);
            PG8_WAIT_V(6); PG8_BAR; PG8_MMA(1, 1, At, B1); PG8_BAR;
            PG8_LDB(B0, 1, 0); PG8_SCHED; PG8_LDA(At, 1, 0); PG8_STAGE(PG8_SA(0, 1), a2 + hstep);
            PG8_WAIT_L(8); PG8_BAR; PG8_WAIT_L(0); PG8_MMA(0, 0, At, B0); PG8_BAR; PG8_SCHED;
            PG8_LDB(B1, 1, 1); PG8_STAGE(PG8_SB(1, 0), b3);
            PG8_BAR; PG8_WAIT_L(0); PG8_MMA(0, 1, At, B1); PG8_BAR;
            PG8_LDA(At, 1, 1); PG8_STAGE(PG8_SA(1, 0), a3);
            PG8_BAR; PG8_WAIT_L(0); PG8_MMA(1, 0, At, B0); PG8_BAR; PG8_SCHED;
            PG8_STAGE(PG8_SB(1, 1), b3 + hstep);
            PG8_WAIT_V(6); PG8_BAR; PG8_MMA(1, 1, At, B1); PG8_BAR;
            }
        }
        if constexpr (ALIGN_EPI) { if (wr == 0) PG8_BAR; }
        const bool keep = E(acc, cur, wr, wc, fr, fq);
        if (!has_next) break;
        if (!keep) PG8_ZERO();
        cur = nxt; cA = nA; cB = nB; ++ui;
        if constexpr (ALIGN_EPI) { if (wr == 1) PG8_BAR; }
    }
    PG8_WAIT_V(0);
    if constexpr (!ALIGN_EPI) { if (wr == 0) PG8_BAR; }
    PG8_BAR;
#undef PG8_SA
#undef PG8_SB
#undef PG8_STAGE
#undef PG8_LDA
#undef PG8_LDB
#undef PG8_MMA
#undef PG8_WAIT_V
#undef PG8_WAIT_L
#undef PG8_BAR
#undef PG8_SCHED
#undef PG8_ZERO
}

struct EpiXupd {
    const float* xin; float* xout; const float* gate0;
    float cs;
    __device__ __forceinline__ bool operator()(f32x4 (&acc)[2][2][4][2], const Unit& u, int wr, int wc, int fr, int fq) const {
        const int row0 = u.pm * BM + wr * 64 + fr, col0 = u.pn * BM + wc * 32 + 4 * fq;
        const float* gp = gate0 + (size_t)(u.pm >> 3) * NADA + col0;
        f32x4 cv[2][2];
#pragma unroll
        for (int bj = 0; bj < 2; ++bj)
#pragma unroll
            for (int n = 0; n < 2; ++n) cv[bj][n] = *(const f32x4*)(gp + bj * HALF + n * 16) * cs;
#pragma unroll
        for (int ai = 0; ai < 2; ++ai)
#pragma unroll
            for (int m = 0; m < 4; ++m) { const size_t off = (size_t)(row0 + ai * HALF + m * 16) * D + col0;
#pragma unroll
                for (int bj = 0; bj < 2; ++bj)
#pragma unroll
                    for (int n = 0; n < 2; ++n) { const f32x4 xv = *(const f32x4*)(xin + off + bj * HALF + n * 16); *(f32x4*)(xout + off + bj * HALF + n * 16) = xv + cv[bj][n] * acc[ai][bj][m][n]; } }
        return false;
    }
};

__device__ __forceinline__ float silu_f(float g) { return g * __builtin_amdgcn_rcpf(1.0f + __expf(-g)); }
__device__ __forceinline__ float sigm_f(float g) { return __builtin_amdgcn_rcpf(1.0f + __expf(-g)); }
struct EpiSwiglu {
    bf16* act;
    __device__ __forceinline__ bool operator()(f32x4 (&acc)[2][2][4][2], const Unit& u, int wr, int wc, int fr, int fq) const {
        const int row0 = u.pm * BM + wr * 64 + fr, col0 = u.pn * HALF + wc * 32 + 8 * fq;
#pragma unroll
        for (int ai = 0; ai < 2; ++ai)
#pragma unroll
            for (int m = 0; m < 4; ++m) {
                const f32x4 g0 = acc[ai][0][m][0], g1 = acc[ai][0][m][1], u0 = acc[ai][1][m][0], u1 = acc[ai][1][m][1];
                u32x4 w;
                w.x = pk2(silu_f(g0[0]) * u0[0], silu_f(g0[1]) * u0[1]); w.y = pk2(silu_f(g0[2]) * u0[2], silu_f(g0[3]) * u0[3]);
                w.z = pk2(silu_f(g1[0]) * u1[0], silu_f(g1[1]) * u1[1]); w.w = pk2(silu_f(g1[2]) * u1[2], silu_f(g1[3]) * u1[3]);
                *(u32x4*)(act + (size_t)(row0 + ai * HALF + m * 16) * DFF + col0) = w;
            }
        return false;
    }
};
struct EpiQkvg {
    bf16* out;
    __device__ __forceinline__ bool operator()(f32x4 (&acc)[2][2][4][2], const Unit& u, int wr, int wc, int fr, int fq) const {
        const int row0 = u.pm * BM + wr * 64 + fr;
#pragma unroll
        for (int bj = 0; bj < 2; ++bj) {
            const int c = u.pn * BM + bj * HALF;
            const bool isq = (c < C_KSB) || (c >= C_QDIL && c < C_KDIL) || (c >= C_QSWA && c < C_KSWA), isg = c >= C_GATE;
            const int col0 = c + wc * 32 + 8 * fq;
#pragma unroll
            for (int ai = 0; ai < 2; ++ai)
#pragma unroll
                for (int m = 0; m < 4; ++m) {
                    f32x4 v0 = acc[ai][bj][m][0], v1 = acc[ai][bj][m][1];
                    if (isq) { v0 = v0 * QSCALE; v1 = v1 * QSCALE; }
                    if (isg) {
#pragma unroll
                        for (int e = 0; e < 4; ++e) { v0[e] = sigm_f(v0[e]); v1[e] = sigm_f(v1[e]); } }
                    u32x4 w; w.x = pk2(v0[0], v0[1]); w.y = pk2(v0[2], v0[3]); w.z = pk2(v1[0], v1[1]); w.w = pk2(v1[2], v1[3]);
                    *(u32x4*)(out + (size_t)(row0 + ai * HALF + m * 16) * DIN + col0) = w;
                }
        }
        return false;
    }
};
struct EpiBranch {
    const bf16* gates;
    bf16* out;
    __device__ __forceinline__ bool operator()(f32x4 (&acc)[2][2][4][2], const Unit& u, int wr, int wc, int fr, int fq) const {
        const int row0 = u.pm * BM + wr * 64 + fr; const int br = u.br;
#pragma unroll
        for (int ai = 0; ai < 2; ++ai)
#pragma unroll
            for (int m = 0; m < 4; ++m)
#pragma unroll
                for (int bj = 0; bj < 2; ++bj) {
                    const int row = row0 + ai * HALF + m * 16, col0 = u.pn * BM + bj * HALF + wc * 32 + 8 * fq;
                    const u32x4 sc = *(const u32x4*)(gates + (size_t)row * DIN + br * D + col0);
                    float f[8] = {bf2f(sc.x & 0xffffu), bf2f(sc.x >> 16), bf2f(sc.y & 0xffffu), bf2f(sc.y >> 16), bf2f(sc.z & 0xffffu), bf2f(sc.z >> 16), bf2f(sc.w & 0xffffu), bf2f(sc.w >> 16)};
                    if (br < 2) {
                        const u32x4 sn = *(const u32x4*)(gates + (size_t)row * DIN + (br + 1) * D + col0);
                        const float d[8] = {bf2f(sn.x & 0xffffu), bf2f(sn.x >> 16), bf2f(sn.y & 0xffffu), bf2f(sn.y >> 16), bf2f(sn.z & 0xffffu), bf2f(sn.z >> 16), bf2f(sn.w & 0xffffu), bf2f(sn.w >> 16)};
#pragma unroll
                        for (int e = 0; e < 8; ++e) f[e] = f[e] * __builtin_amdgcn_rcpf(fmaxf(d[e], 1e-30f));
                    }
                    f32x4 v0 = acc[ai][bj][m][0], v1 = acc[ai][bj][m][1];
                    v0[0] *= f[0]; v0[1] *= f[1]; v0[2] *= f[2]; v0[3] *= f[3]; v1[0] *= f[4]; v1[1] *= f[5]; v1[2] *= f[6]; v1[3] *= f[7];
                    if (br < 2) { acc[ai][bj][m][0] = v0; acc[ai][bj][m][1] = v1; }
                    else { u32x4 w; w.x = pk2(v0[0], v0[1]); w.y = pk2(v0[2], v0[3]); w.z = pk2(v1[0], v1[1]); w.w = pk2(v1[2], v1[3]); *(u32x4*)(out + (size_t)row * D + col0) = w; }
                }
        return br < 2;
    }
};
}

__device__ __forceinline__ void ph_xupd(Frame& F, const bf16* A, int K, const bf16* Bt, const float* xin, float* xout, int l, int j, float cs) {
    pg8::Gemm g{A, Bt, K}; pg8::OrderK S; S.init(M, D, F.G, F.wg); S.ntiles = K / 64;
    pg8::EpiXupd E{xin, xout, F.mod + (size_t)l * BATCH * NADA + (j * 3 + 2) * D, cs};
    pg8::gemm_phase<pg8::EpiXupd, pg8::OrderK, false, true>(F.lds, g, S, E);
}


__device__ __forceinline__ void ph_ffn_up(Frame& F, const bf16* Bt) {
    pg8::Gemm g{F.H, Bt, D}; pg8::OrderK S; S.init(M, 2 * DFF, F.G, F.wg); S.ntiles = D / 64;
    pg8::EpiSwiglu E{F.ACT};
    pg8::gemm_phase<pg8::EpiSwiglu, pg8::OrderK, true, true>(F.lds, g, S, E);
}
__device__ __forceinline__ void ph_inproj(Frame& F) {
    pg8::Gemm g{F.H, (const bf16*)(F.ws + WS_W + WO_IN), D}; pg8::OrderK S; S.init(M, DIN, F.G, F.wg); S.ntiles = D / 64;
    pg8::EpiQkvg E{F.QKVG};
    pg8::gemm_phase<pg8::EpiQkvg, pg8::OrderK, true, true>(F.lds, g, S, E);
}
__device__ __forceinline__ void ph_branch(Frame& F) {
    pg8::Gemm g{F.OCAT, (const bf16*)(F.ws + WS_W + WO_BR), OC}; pg8::OrderBr S; S.init(M, D, F.G, F.wg);
    pg8::EpiBranch E{F.QKVG + C_GATE, F.H};
    pg8::gemm_phase<pg8::EpiBranch, pg8::OrderBr, true, true>(F.lds, g, S, E);
}

namespace att {
typedef float f32x16 __attribute__((ext_vector_type(16)));
typedef short bf16x8 __attribute__((ext_vector_type(8)));
typedef short s16x4 __attribute__((ext_vector_type(4)));
typedef short v4i16_t __attribute__((ext_vector_type(4)));
constexpr int KP = 144, LW_K = 0, LW_V = 4608, LW_F = 8704, LW_BYTES = 9216, LDS_BTAB = 8 * LW_BYTES, BT_PITCH = 132;
#define ATT_FENCE() asm volatile("" ::: "memory")
__device__ __forceinline__ int crow(int r, int h) { return (r & 3) + 8 * (r >> 2) + 4 * h; }
__device__ __forceinline__ s16x4 vtr(const LAS unsigned char* p) { return __builtin_bit_cast(s16x4, __builtin_amdgcn_ds_read_tr16_b64_v4i16((LAS v4i16_t*)p)); }
__device__ __forceinline__ float swap_other(float x, int hh) { auto rr = __builtin_amdgcn_permlane32_swap(__float_as_uint(x), __float_as_uint(x), false, false); return __uint_as_float(hh ? rr[0] : rr[1]); }

struct KVRegs { u32x4 k[4], v[4]; };
__device__ __forceinline__ void kv_issue(KVRegs& R, const bf16* base, int kcol, int vcol, const int (&tok)[4], int lane) {
#pragma unroll
    for (int i = 0; i < 4; ++i) { const bf16* pr = base + (size_t)tok[i] * DIN + (lane & 7) * 8; R.k[i] = *(const u32x4*)(pr + kcol); R.v[i] = *(const u32x4*)(pr + vcol); }
}
__device__ __forceinline__ void kv_write(LAS unsigned char* wl, const KVRegs& R, int lane) {
    const int row = lane >> 3, ch = lane & 7;
    ATT_FENCE();
#pragma unroll
    for (int i = 0; i < 4; ++i) { *(LAS u32x4*)(wl + LW_K + (row + 8 * i) * KP + ch * 16) = R.k[i]; *(LAS u32x4*)(wl + LW_V + (ch >> 2) * 2048 + (row + 8 * i) * 64 + (ch & 3) * 16) = R.v[i]; }
    ATT_FENCE();
}
__device__ __forceinline__ f32x16 qk_tile(const LAS unsigned char* wl, const bf16x8 (&qf)[4], int lane) {
    const LAS unsigned char* kp = wl + LW_K + (lane & 31) * KP + (lane >> 5) * 16;
    f32x16 S = {};
#pragma unroll
    for (int d0 = 0; d0 < 4; ++d0) { const bf16x8 kf = *(const LAS bf16x8*)(kp + d0 * 32); S = __builtin_amdgcn_mfma_f32_32x32x16_bf16(kf, qf[d0], S, 0, 0, 0); }
    return S;
}
__device__ __forceinline__ void pv_tile(const LAS unsigned char* wl, const float (&w)[16], f32x16& o0, f32x16& o1, int lane) {
    const int hh = lane >> 5;
    const LAS unsigned char* vp = wl + LW_V + ((lane >> 4) & 1) * 32 + (lane & 3) * 8 + (4 * hh + ((lane & 15) >> 2)) * 64;
#pragma unroll
    for (int s2 = 0; s2 < 2; ++s2) {
        u32x4 pw; pw.x = pk2(w[8 * s2 + 0], w[8 * s2 + 1]); pw.y = pk2(w[8 * s2 + 2], w[8 * s2 + 3]); pw.z = pk2(w[8 * s2 + 4], w[8 * s2 + 5]); pw.w = pk2(w[8 * s2 + 6], w[8 * s2 + 7]);
        const bf16x8 pa = __builtin_bit_cast(bf16x8, pw);
#pragma unroll
        for (int dh = 0; dh < 2; ++dh) {
            const s16x4 lo = vtr(vp + dh * 2048 + s2 * 1024), hi = vtr(vp + dh * 2048 + s2 * 1024 + 512);
            const bf16x8 vf = {lo[0], lo[1], lo[2], lo[3], hi[0], hi[1], hi[2], hi[3]};
            if (dh == 0) o0 = __builtin_amdgcn_mfma_f32_32x32x16_bf16(pa, vf, o0, 0, 0, 0); else o1 = __builtin_amdgcn_mfma_f32_32x32x16_bf16(pa, vf, o1, 0, 0, 0);
        }
    }
}
__device__ __forceinline__ void store_o(LAS unsigned char* wl, const f32x16& o0, const f32x16& o1, float qscale, bf16* dst, const int (&qtok)[4], int lane) {
    const int r = lane & 31, hh = lane >> 5;
    LAS float* fs = (LAS float*)(wl + LW_F); LAS unsigned short* stg = (LAS unsigned short*)(wl + LW_K);
    ATT_FENCE();
    if (hh == 0) fs[r] = qscale;
    ATT_FENCE();
#pragma unroll
    for (int gi = 0; gi < 4; ++gi) { const f32x4 sc = *(const LAS f32x4*)(fs + 8 * gi + 4 * hh);
#pragma unroll
        for (int e = 0; e < 4; ++e) { const int q = 8 * gi + 4 * hh + e; stg[q * 64 + r] = (unsigned short)f2bf(o0[4 * gi + e] * sc[e]); stg[q * 64 + 32 + r] = (unsigned short)f2bf(o1[4 * gi + e] * sc[e]); } }
    ATT_FENCE();
#pragma unroll
    for (int i = 0; i < 4; ++i) { const int row = (lane >> 3) + 8 * i; const u32x4 v = *(const LAS u32x4*)(stg + row * 64 + (lane & 7) * 8); *(u32x4*)(dst + (size_t)qtok[i] * OC + (lane & 7) * 8) = v; }
    ATT_FENCE();
}

__device__ __forceinline__ void sb_item(const bf16* qkvg, bf16* ocat, int b, int h, int qt, LAS unsigned char* wl, int lane) {
    const int r = lane & 31, hh = lane >> 5; const bf16* base = qkvg + (size_t)b * SEQ * DIN;
    bf16x8 qf[4];
#pragma unroll
    for (int d0 = 0; d0 < 4; ++d0) qf[d0] = *(const bf16x8*)(base + (size_t)(qt * 32 + r) * DIN + C_QSB + h * HD + 16 * d0 + 8 * hh);
    f32x16 o0 = {}, o1 = {}; float carry = 1.0f;
    for (int kt = qt; kt >= 0; --kt) {
        int tok[4];
#pragma unroll
        for (int i = 0; i < 4; ++i) tok[i] = kt * 32 + (lane >> 3) + 8 * i;
        KVRegs R; kv_issue(R, base, C_KSB + h * HD, C_VSB + h * HD, tok, lane); kv_write(wl, R, lane);
        const f32x16 S = qk_tile(wl, qf, lane);
        float f[16], be[16];
#pragma unroll
        for (int g = 0; g < 16; ++g) { const float e = __builtin_amdgcn_exp2f(fminf(S[g], 80.f)); const float fr = __builtin_amdgcn_rcpf(1.0f + e); f[g] = fr; be[g] = e * fr; }
        if (kt == qt) {
#pragma unroll
            for (int g = 0; g < 16; ++g) { const bool valid = crow(g, hh) < r; f[g] = valid ? f[g] : 1.0f; be[g] = valid ? be[g] : 0.0f; }
        }
        float X[16], T0[4], T1[4];
#pragma unroll
        for (int gi = 0; gi < 4; ++gi) { const float L3 = f[4 * gi + 3], L2 = f[4 * gi + 2] * L3, L1 = f[4 * gi + 1] * L2, L0 = f[4 * gi] * L1;
            X[4 * gi + 3] = 1.0f; X[4 * gi + 2] = L3; X[4 * gi + 1] = L2; X[4 * gi] = L1;
            auto rr = __builtin_amdgcn_permlane32_swap(__float_as_uint(L0), __float_as_uint(L0), false, false); T0[gi] = __uint_as_float(rr[0]); T1[gi] = __uint_as_float(rr[1]); }
        float E[4]; E[3] = carry; E[2] = E[3] * (T0[3] * T1[3]); E[1] = E[2] * (T0[2] * T1[2]); E[0] = E[1] * (T0[1] * T1[1]); carry = E[0] * (T0[0] * T1[0]);
        float w[16];
#pragma unroll
        for (int g = 0; g < 16; ++g) { const float eg = hh ? E[g >> 2] : E[g >> 2] * T1[g >> 2]; w[g] = be[g] * (eg * X[g]); }
        pv_tile(wl, w, o0, o1, lane);
        if (__all(carry < 1.2e-38f)) break;
    }
    int qtok[4];
#pragma unroll
    for (int i = 0; i < 4; ++i) qtok[i] = qt * 32 + (lane >> 3) + 8 * i;
    store_o(wl, o0, o1, 1.0f, ocat + (size_t)b * SEQ * OC + h * HD, qtok, lane);
}

struct BandState { float m, l; f32x16 o0, o1; };
__device__ __forceinline__ void band_group(BandState& st, const bf16* base, int qtok, int qcol, int kcol, int vcol, int d, int sstep, int P0, int kres, int NT, int maxd,
                                           const LAS float* bt, LAS unsigned char* wl, int lane) {
    const int r = lane & 31, hh = lane >> 5;
    LAS float* fs = (LAS float*)(wl + LW_F);
    bf16x8 qf[4];
#pragma unroll
    for (int d0 = 0; d0 < 4; ++d0) qf[d0] = *(const bf16x8*)(base + (size_t)qtok * DIN + qcol + 16 * d0 + 8 * hh);
    for (int c = 0; c < NT; ++c) {
        const int idx0 = P0 - 128 + 32 * c;
        if (idx0 + 31 < 0) continue;
        int tok[4];
#pragma unroll
        for (int i = 0; i < 4; ++i) { const int ix = idx0 + (lane >> 3) + 8 * i; const int tk = kres + d * (ix < 0 ? 0 : ix); tok[i] = tk > SEQ - 1 ? SEQ - 1 : tk; }
        KVRegs R; kv_issue(R, base, kcol, vcol, tok, lane); kv_write(wl, R, lane);
        const f32x16 S = qk_tile(wl, qf, lane);
        float sc[16]; bool valid[16]; float mx = -1e30f;
#pragma unroll
        for (int g = 0; g < 16; ++g) { const int k = crow(g, hh), rel = sstep * r + 128 - 32 * c - k; valid[g] = (rel >= 0) && (rel <= maxd) && (idx0 + k >= 0);
            const int ri = rel < 0 ? 0 : (rel > 128 ? 128 : rel); sc[g] = S[g] + bt[ri]; mx = fmaxf(mx, valid[g] ? sc[g] : -1e30f); }
        mx = fmaxf(mx, swap_other(mx, hh));
        if (__any(mx > st.m + 8.0f)) {
            const float mn = fmaxf(st.m, mx), fsc = __builtin_amdgcn_exp2f(st.m - mn); st.l *= fsc; st.m = mn;
            ATT_FENCE(); if (hh == 0) fs[r] = fsc; ATT_FENCE();
#pragma unroll
            for (int gi = 0; gi < 4; ++gi) { const f32x4 fv = *(const LAS f32x4*)(fs + 8 * gi + 4 * hh);
#pragma unroll
                for (int e = 0; e < 4; ++e) { st.o0[4 * gi + e] *= fv[e]; st.o1[4 * gi + e] *= fv[e]; } }
            ATT_FENCE();
        }
        float w[16]; float ls = 0.f;
#pragma unroll
        for (int g = 0; g < 16; ++g) { w[g] = valid[g] ? __builtin_amdgcn_exp2f(sc[g] - st.m) : 0.0f; ls += w[g]; }
        st.l += ls;
        pv_tile(wl, w, st.o0, st.o1, lane);
    }
}
}

__device__ __forceinline__ void ph_attn(Frame& F, int l) {
    using namespace att;
    LAS float* btab = (LAS float*)(F.lds + LDS_BTAB);
    const float* relb = F.in[I_RELB];
    for (int idx = F.tid; idx < 12 * 129; idx += NTHREADS) { const int head = idx / 129, rel = idx % 129; const int dd = head < 2 ? 1 : (head < 4 ? 4 : (head < 6 ? 16 : 1));
        btab[head * BT_PITCH + rel] = relb[t5_bucket(rel * dd) * 12 + head] * LOG2E; }
    __syncthreads();
    LAS unsigned char* wl = F.lds + F.wave * LW_BYTES;
    const int lane = F.lane, r = lane & 31, hh = lane >> 5;
    const int gw = F.wg * (NTHREADS / 64) + F.wave, NGW = F.G * (NTHREADS / 64);
    for (int it = gw; it < 1024 + 2048 + 3072; it += NGW) {
        if (it < 1024) {
            const int b = it >> 7, slot = (it >> 6) & 1, r16 = (it >> 2) & 15, i0 = (it & 3) * 32;
            const bf16* base = F.QKVG + (size_t)b * SEQ * DIN; const int qtok = r16 + 16 * (i0 + r);
            BandState st; st.m = -1e30f; st.l = 0.f; st.o0 = f32x16{}; st.o1 = f32x16{};
            band_group(st, base, qtok, C_QDIL + (4 + slot) * HD, C_KDIL + (4 + slot) * HD, C_VDIL + (4 + slot) * HD, 16, 1, i0, r16, 5, 128, btab + (4 + slot) * BT_PITCH, wl, lane);
            band_group(st, base, qtok, C_QDIL + (2 + slot) * HD, C_KDIL + (2 + slot) * HD, C_VDIL + (2 + slot) * HD, 4, 4, (r16 >> 2) + 4 * i0, r16 & 3, 8, 128, btab + (2 + slot) * BT_PITCH, wl, lane);
            band_group(st, base, qtok, C_QDIL + slot * HD, C_KDIL + slot * HD, C_VDIL + slot * HD, 1, 16, r16 + 16 * i0, 0, 20, 128, btab + slot * BT_PITCH, wl, lane);
            const float lt = st.l + swap_other(st.l, hh);
            int qt4[4];
#pragma unroll
            for (int i = 0; i < 4; ++i) qt4[i] = r16 + 16 * (i0 + (lane >> 3) + 8 * i);
            store_o(wl, st.o0, st.o1, 1.0f / lt, F.OCAT + (size_t)b * SEQ * OC + 256 + slot * HD, qt4, lane);
        } else if (it < 3072) {
            const int x = it - 1024, qt = 63 - (x >> 5), b = (x & 31) >> 2, h = x & 3;
            sb_item(F.QKVG, F.OCAT, b, h, qt, wl, lane);
        } else {
            const int x = it - 3072, hq = x % 6, qt = (x / 6) % 64, b = x / 384, kv = hq / 3;
            const bf16* base = F.QKVG + (size_t)b * SEQ * DIN;
            const float sk = F.in[I_SINKS][l * 6 + hq] * LOG2E;
            BandState st; st.m = sk; st.l = 0.f; st.o0 = f32x16{}; st.o1 = f32x16{};
            band_group(st, base, qt * 32 + r, C_QSWA + hq * HD, C_KSWA + kv * HD, C_VSWA + kv * HD, 1, 1, qt * 32, 0, 5, 127, btab + (6 + hq) * BT_PITCH, wl, lane);
            const float lt = st.l + swap_other(st.l, hh) + __builtin_amdgcn_exp2f(sk - st.m);
            int qt4[4];
#pragma unroll
            for (int i = 0; i < 4; ++i) qt4[i] = qt * 32 + (lane >> 3) + 8 * i;
            store_o(wl, st.o0, st.o1, 1.0f / lt, F.OCAT + (size_t)b * SEQ * OC + 384 + hq * HD, qt4, lane);
        }
    }
}

#define XB_TMO      128
#define XB_XCNT(j)  (256  + 64 * (j))
#define XB_XSUB(j)  (1280 + 64 * (j))
#define XB_XGEN(j)  (2304 + 64 * (j))
#define XB_TOP      3328
#define XB_TOPGEN   3392
#define XCD_BAR_WORDS 3456
#define XB_SPIN_CAP (1u << 18)
__device__ __forceinline__ unsigned xb_ld(unsigned* p)              { return __hip_atomic_load(p, __ATOMIC_RELAXED, __HIP_MEMORY_SCOPE_AGENT); }
__device__ __forceinline__ unsigned xb_add(unsigned* p, unsigned v) { return __hip_atomic_fetch_add(p, v, __ATOMIC_RELAXED, __HIP_MEMORY_SCOPE_AGENT); }
__device__ __forceinline__ unsigned xb_xcc_id() { return (unsigned)__builtin_amdgcn_s_getreg((3 << 11) | 20) & 0xFu; }
#define XB_SPIN(cond, bar) do { unsigned _sp = 0; while (cond) { __builtin_amdgcn_s_sleep(1); \
    if ((++_sp & 255u) == 0u) { if (xb_ld(&(bar)[XB_TMO])) break; if (_sp > XB_SPIN_CAP) { atomicAdd(&(bar)[XB_TMO], 1u); break; } } } } while (0)
struct XcdBarrier { unsigned* bar; unsigned x; volatile LAS unsigned* st; };
__device__ __forceinline__ XcdBarrier xcd_barrier_post(unsigned* bar, volatile LAS unsigned* st) {
    XcdBarrier b; b.bar = bar; b.x = xb_xcc_id(); b.st = st;
    if (threadIdx.x == 0) (void)xb_add(&bar[XB_XCNT(b.x)], 1u);
    return b;
}
__device__ __forceinline__ void xcd_barrier_complete(unsigned* bar, unsigned x, unsigned& nloc, unsigned& nx) {
    const unsigned G = gridDim.x * gridDim.y * gridDim.z;
    unsigned sum, cnt, mine, sp = 0u;
    for (;;) {
        sum = 0u; cnt = 0u; mine = 0u;
#pragma unroll
        for (unsigned j = 0; j < 16; ++j) { const unsigned c = xb_ld(&bar[XB_XCNT(j)]); sum += c; cnt += (c > 0u) ? 1u : 0u; mine = (j == x) ? c : mine; }
        if (sum == G) break;
        __builtin_amdgcn_s_sleep(1);
        if ((++sp & 255u) == 0u) { if (xb_ld(&bar[XB_TMO])) break; if (sp > XB_SPIN_CAP) { atomicAdd(&bar[XB_TMO], 1u); break; } }
    }
    nloc = mine > 0u ? mine : 1u; nx = cnt > 0u ? cnt : 1u;
}
__device__ __forceinline__ void xcd_barrier(const XcdBarrier& b) {
    asm volatile("s_waitcnt vmcnt(0)" ::: "memory");
    __syncthreads();
    if (threadIdx.x == 0) {
        unsigned* bar = b.bar;
        __builtin_amdgcn_s_waitcnt(0);
        unsigned nloc = b.st[0], nx = b.st[1];
        if (nloc == 0u) { xcd_barrier_complete(bar, b.x, nloc, nx); b.st[0] = nloc; b.st[1] = nx; }
        const unsigned old = xb_add(&bar[XB_XSUB(b.x)], 1u);
        const unsigned gen = old / nloc;
        if (old + 1u == (gen + 1u) * nloc) {
            __builtin_amdgcn_fence(__ATOMIC_RELEASE, "agent");
            asm volatile("s_waitcnt vmcnt(0)" ::: "memory");
            const unsigned og = xb_add(&bar[XB_TOP], 1u);
            const unsigned tg = og / nx;
            if (og + 1u == (tg + 1u) * nx) xb_add(&bar[XB_TOPGEN], 1u);
            else XB_SPIN(xb_ld(&bar[XB_TOPGEN]) == tg, bar);
            __builtin_amdgcn_fence(__ATOMIC_ACQUIRE, "agent");
            xb_add(&bar[XB_XGEN(b.x)], 1u);
            asm volatile("s_waitcnt vmcnt(0)" ::: "memory");
        } else {
            XB_SPIN(xb_ld(&bar[XB_XGEN(b.x)]) == gen, bar);
            __builtin_amdgcn_fence(__ATOMIC_ACQUIRE, "agent");
            asm volatile("s_waitcnt vmcnt(0)" ::: "memory");
        }
    }
    __syncthreads();
}

#ifndef MK_ONE_LAUNCH
#define MK_ONE_LAUNCH 1
#endif
constexpr int NPHASE = 2 + 11 * DEPTH;
constexpr int RING_BYTES = 131072, MISC_OFF = RING_BYTES + 320, LDS_BYTES = 147456;
constexpr int CTL_ZERO_BYTES = 16384;
static_assert(XCD_BAR_WORDS * 4 <= CTL_ZERO_BYTES && att::LDS_BTAB + 12 * att::BT_PITCH * 4 <= RING_BYTES, "maps");

__global__ void __launch_bounds__(NTHREADS, 2) mk_fwd(Args a) {
    extern __shared__ __attribute__((aligned(16))) unsigned char lds[];
    Frame F;
    F.lds = (LAS unsigned char*)lds; F.tid = threadIdx.x; F.lane = F.tid & 63; F.wave = __builtin_amdgcn_readfirstlane(F.tid >> 6); F.G = gridDim.x; F.wg = blockIdx.x;
#pragma unroll
    for (int i = 0; i < 16; ++i) F.in[i] = a.in[i];
    F.X = a.out; F.ws = a.ws; F.mod = (float*)(a.ws + WS_MOD); F.H = (bf16*)(a.ws + WS_H); F.OCAT = (bf16*)(a.ws + WS_OCAT); F.QKVG = (bf16*)(a.ws + WS_BIG); F.ACT = (bf16*)(a.ws + WS_BIG);
    volatile LAS unsigned* MISC = (volatile LAS unsigned*)(F.lds + MISC_OFF);
    if (F.tid < 32) MISC[F.tid] = 0u;
    __syncthreads();
    const int lo = a.ph_lo, hi = a.ph_hi;
    XcdBarrier bar; bar.bar = (unsigned*)(a.ws + WS_CTL); bar.x = 0; bar.st = nullptr;
    if (hi - lo > 1) bar = xcd_barrier_post((unsigned*)(a.ws + WS_CTL), MISC + 8);
    unsigned char* const wb = a.ws + WS_W;
#define PHASE(k, ...) do { if (lo <= (k) && (k) < hi) { __VA_ARGS__; if ((k) + 1 < hi) xcd_barrier(bar); } } while (0)
#define LAYER(l, XIN0) \
    PHASE(1 + 11 * (l) + 0, if ((l) > 0) ph_convert(F, (l)); ph_prep(F, (XIN0), (l), 0)); \
    PHASE(1 + 11 * (l) + 1, ph_ffn_up(F, (const bf16*)(wb + WO_GU0))); \
    PHASE(1 + 11 * (l) + 2, ph_xupd(F, F.ACT, DFF, (const bf16*)(wb + WO_D0), (XIN0), F.X, (l), 0, 0.5f)); \
    PHASE(1 + 11 * (l) + 3, ph_prep(F, F.X, (l), 1)); \
    PHASE(1 + 11 * (l) + 4, ph_inproj(F)); \
    PHASE(1 + 11 * (l) + 5, ph_attn(F, (l))); \
    PHASE(1 + 11 * (l) + 6, ph_branch(F)); \
    PHASE(1 + 11 * (l) + 7, ph_xupd(F, F.H, D, (const bf16*)(wb + WO_OUT), F.X, F.X, (l), 1, 1.0f)); \
    PHASE(1 + 11 * (l) + 8, ph_prep(F, F.X, (l), 2)); \
    PHASE(1 + 11 * (l) + 9, ph_ffn_up(F, (const bf16*)(wb + WO_GU1))); \
    PHASE(1 + 11 * (l) + 10, ph_xupd(F, F.ACT, DFF, (const bf16*)(wb + WO_D1), F.X, F.X, (l), 2, 0.5f))
    PHASE(0, ph_adaln_naive(F); ph_convert(F, 0));
    LAYER(0, F.in[I_X]);
    LAYER(1, F.X);
    PHASE(NPHASE - 1, ph_final(F));
#undef LAYER
#undef PHASE
}

extern "C" void kernel_launch(void* const* d_in, const int* in_sizes, int n_in, void* d_out, int out_size, void* d_ws, size_t ws_size, hipStream_t stream) {
    static int grid = 0;
    if (grid == 0) {
        if (n_in != 16 || in_sizes[0] != M * D || out_size != M * D || ws_size < WS_END) { fprintf(stderr, "kernel_launch: unexpected shapes (n_in %d, in0 %d, out %d, ws %zu)\n", n_in, n_in > 0 ? in_sizes[0] : -1, out_size, ws_size); grid = -1; return; }
        int dev = 0, cus = 0, per_cu = 0;
        if (hipGetDevice(&dev) != hipSuccess || hipDeviceGetAttribute(&cus, hipDeviceAttributeMultiprocessorCount, dev) != hipSuccess) { grid = -1; return; }
        if (hipFuncSetAttribute((const void*)mk_fwd, hipFuncAttributeMaxDynamicSharedMemorySize, LDS_BYTES) != hipSuccess) { fprintf(stderr, "kernel_launch: hipFuncSetAttribute failed\n"); grid = -1; return; }
        if (hipOccupancyMaxActiveBlocksPerMultiprocessor(&per_cu, (const void*)mk_fwd, NTHREADS, LDS_BYTES) != hipSuccess || per_cu < 1) { fprintf(stderr, "kernel_launch: occupancy query reports %d workgroups per CU\n", per_cu); (void)hipGetLastError(); grid = -1; return; }
        grid = cus;
    }
    if (grid < 0) return;
    Args a{};
    for (int i = 0; i < 16; ++i) a.in[i] = (const float*)d_in[i];
    a.out = (float*)d_out; a.ws = (unsigned char*)d_ws;
#if MK_ONE_LAUNCH
    (void)hipMemsetAsync((char*)d_ws + WS_CTL, 0, CTL_ZERO_BYTES, stream);
    a.ph_lo = 0; a.ph_hi = NPHASE;
    hipLaunchKernelGGL(mk_fwd, dim3(grid), dim3(NTHREADS), LDS_BYTES, stream, a);
#else
    for (int ph = 0; ph < NPHASE; ++ph) { a.ph_lo = ph; a.ph_hi = ph + 1; hipLaunchKernelGGL(mk_fwd, dim3(grid), dim3(NTHREADS), LDS_BYTES, stream, a); }
#endif
}
```

```cpp
#include <hip/hip_runtime.h>
#include <cstdio>
#include <cstdint>

#define LAS __attribute__((address_space(3)))
typedef unsigned short bf16;
typedef float f32x4 __attribute__((ext_vector_type(4)));
typedef unsigned u32x2 __attribute__((ext_vector_type(2)));
typedef unsigned u32x4 __attribute__((ext_vector_type(4)));

constexpr int D = 1024, BATCH = 8, SEQ = 2048, M = BATCH * SEQ, DEPTH = 2, HD = 64;
constexpr int DFF = 2816, DIN = 5632, NADA = 9216;
constexpr int C_QSB = 0, C_KSB = 256, C_VSB = 512, C_QDIL = 768, C_KDIL = 1152, C_VDIL = 1536, C_QSWA = 1920, C_KSWA = 2304, C_VSWA = 2432, C_GATE = 2560;
constexpr int OC = 768;
constexpr float RMS_EPS = 1e-6f;
constexpr float QSCALE = 0.125f * 1.4426950408889634f;
constexpr float LOG2E = 1.4426950408889634f;
constexpr int NTHREADS = 512;

constexpr size_t MiB = 1u << 20;
constexpr size_t WS_CTL = 0, WS_MOD = 65536, ZERO_BYTES = 655360;
constexpr size_t WS_SS = 1 * MiB, WS_SW = MiB + MiB / 2, WS_SW_END = WS_SW + (size_t)DEPTH * 3 * BATCH * DIN * 4;
constexpr size_t WS_W = 4 * MiB, WS_H = 52 * MiB, WS_OCAT = 84 * MiB, WS_BIG = 108 * MiB, WS_H2 = 284 * MiB, WS_END = 316 * MiB;
static_assert(WS_MOD + (size_t)DEPTH * BATCH * NADA * 4 <= ZERO_BYTES && WS_SS + 7 * (size_t)M * 4 <= WS_SW && WS_SW_END <= WS_W, "ws map");

enum { I_X = 0, I_C, I_WADA, I_BADA, I_NG, I_WG, I_WU, I_WD, I_WIN, I_WBSB, I_WBDIL, I_WBSWA, I_WOUT, I_SINKS, I_RELB, I_FG };

struct Args { const float* in[16]; float* out; unsigned char* ws; int ph_lo, ph_hi; };

__device__ __forceinline__ unsigned f2bf(float f) { unsigned u = __builtin_bit_cast(unsigned, f); return (u + 0x7fffu + ((u >> 16) & 1u)) >> 16; }
__device__ __forceinline__ float bf2f(unsigned b) { return __builtin_bit_cast(float, b << 16); }
__device__ __forceinline__ unsigned pk2(float lo, float hi) { return f2bf(lo) | (f2bf(hi) << 16); }
__device__ __forceinline__ float wave_sum(float v) {
#pragma unroll
    for (int o = 1; o < 64; o <<= 1) v += __shfl_xor(v, o);
    return v;
}
__device__ __forceinline__ float sigmoidf_(float x) { return 1.0f / (1.0f + __expf(-x)); }

struct Frame {
    LAS unsigned char* lds;
    int tid, lane, wave, G, wg;
    const float* in[16];
    float* X;
    float* mod;
    float* SS;
    float* SW;
    bf16 *H, *H2, *OCAT, *QKVG, *ACT;
    unsigned char* ws;
};

__device__ __forceinline__ const float* modp(const Frame& F, int l, int b, int j, int t) { return F.mod + ((size_t)(l * BATCH + b) * NADA) + (j * 3 + t) * D; }

__device__ __forceinline__ float silu_f(float g) { return g * __builtin_amdgcn_rcpf(1.0f + __expf(-g)); }
__device__ __forceinline__ float sigm_f(float g) { return __builtin_amdgcn_rcpf(1.0f + __expf(-g)); }

__device__ __forceinline__ void ph_adaln(Frame& F) {
    { f32x4* z = (f32x4*)(F.ws + WS_SS); const int nz = (int)((WS_SW_END - WS_SS) / 16); for (int i = F.wg * NTHREADS + F.tid; i < nz; i += F.G * NTHREADS) z[i] = (f32x4){0.f, 0.f, 0.f, 0.f}; }
    LAS float* sc = (LAS float*)F.lds; LAS float* red = sc + 8 * 256;
    const float* c = F.in[I_C]; const float* W = F.in[I_WADA]; const float* bb = F.in[I_BADA];
    for (int it = F.wg; it < DEPTH * 36 * 4; it += F.G) {
        const int kq = it & 3, nb = (it >> 2) % 36, l = it / 144;
        for (int i = F.tid; i < 8 * 256; i += NTHREADS) { const float cv = c[(i >> 8) * D + kq * 256 + (i & 255)]; sc[i] = cv * sigm_f(cv); }
        __syncthreads();
        f32x4 acc[8];
#pragma unroll
        for (int b = 0; b < 8; ++b) acc[b] = (f32x4){0.f, 0.f, 0.f, 0.f};
        const float* wp = W + ((size_t)l * D + kq * 256 + F.wave * 32) * NADA + nb * 256 + 4 * F.lane;
#pragma unroll 4
        for (int kk = 0; kk < 32; ++kk) { const f32x4 wv = *(const f32x4*)(wp + (size_t)kk * NADA);
#pragma unroll
            for (int b = 0; b < 8; ++b) acc[b] += sc[b * 256 + F.wave * 32 + kk] * wv; }
#pragma unroll
        for (int b = 0; b < 8; ++b) *(LAS f32x4*)(red + (F.wave * 8 + b) * 256 + 4 * F.lane) = acc[b];
        __syncthreads();
        { const int b = F.tid >> 6, c4 = (F.tid & 63) * 4; f32x4 sum = (f32x4){0.f, 0.f, 0.f, 0.f};
#pragma unroll
          for (int w = 0; w < 8; ++w) sum += *(const LAS f32x4*)(red + (w * 8 + b) * 256 + c4);
          if (kq == 0) sum += *(const f32x4*)(bb + l * NADA + nb * 256 + c4);
          float* dst = F.mod + (size_t)(l * BATCH + b) * NADA + nb * 256 + c4;
          atomicAdd(dst + 0, sum.x); atomicAdd(dst + 1, sum.y); atomicAdd(dst + 2, sum.z); atomicAdd(dst + 3, sum.w); }
        __syncthreads();
    }
}

__device__ __forceinline__ void ph_prep0(Frame& F) {
    const float* xin = F.in[I_X]; const float* g = F.in[I_NG];
    const int gw = F.wg * (NTHREADS / 64) + F.wave, NGW = F.G * (NTHREADS / 64);
    for (int m = gw; m < M; m += NGW) {
        const int b = m / SEQ; const float* sc = modp(F, 0, b, 0, 1);
        const f32x4* xr = (const f32x4*)(xin + (size_t)m * D) + F.lane;
        f32x4 v[4]; float s = 0.f;
#pragma unroll
        for (int i = 0; i < 4; ++i) { v[i] = xr[64 * i]; s += (v[i].x * v[i].x + v[i].y * v[i].y) + (v[i].z * v[i].z + v[i].w * v[i].w); }
        s = wave_sum(s);
        if (F.lane == 0) F.SS[m] = s;
        u32x2* o = (u32x2*)(F.H + (size_t)m * D) + F.lane;
#pragma unroll
        for (int i = 0; i < 4; ++i) {
            const int c0 = 4 * F.lane + 256 * i; const f32x4 gg = *(const f32x4*)(g + c0), ss = *(const f32x4*)(sc + c0);
            const f32x4 y = v[i] * gg * (1.0f + ss);
            u32x2 w; w.x = pk2(y.x, y.y); w.y = pk2(y.z, y.w); o[64 * i] = w;
        }
    }
}
__device__ __forceinline__ void ph_final(Frame& F) {
    const float* g = F.in[I_FG];
    const int gw = F.wg * (NTHREADS / 64) + F.wave, NGW = F.G * (NTHREADS / 64);
    for (int m = gw; m < M; m += NGW) {
        f32x4* xr = (f32x4*)(F.X + (size_t)m * D) + F.lane;
        f32x4 v[4]; float s = 0.f;
#pragma unroll
        for (int i = 0; i < 4; ++i) { v[i] = xr[64 * i]; s += (v[i].x * v[i].x + v[i].y * v[i].y) + (v[i].z * v[i].z + v[i].w * v[i].w); }
        const float rstd = 1.0f / sqrtf(wave_sum(s) * (1.f / D) + RMS_EPS);
#pragma unroll
        for (int i = 0; i < 4; ++i) { const f32x4 gg = *(const f32x4*)(g + 4 * F.lane + 256 * i); xr[64 * i] = v[i] * rstd * gg; }
    }
}

__device__ __forceinline__ int t5_bucket(int n) {
    if (n < 16) return n;
    int b = 16;
    b += (n >= 22); b += (n >= 30); b += (n >= 40); b += (n >= 54); b += (n >= 73); b += (n >= 99); b += (n >= 134); b += (n >= 182);
    b += (n >= 246); b += (n >= 332); b += (n >= 450); b += (n >= 609); b += (n >= 825); b += (n >= 1117); b += (n >= 1513); b += (n >= 2048);
    return b > 31 ? 31 : b;
}
constexpr size_t WO_GU0 = 0, WO_D0 = 11 * MiB, WO_GU1 = 16 * MiB + MiB / 2, WO_D1 = 27 * MiB + MiB / 2, WO_IN = 33 * MiB, WO_BR = 44 * MiB, WO_OUT = 45 * MiB + MiB / 2;
static_assert(WS_W + WO_OUT + 2 * MiB <= WS_H, "weight copies fit below H");
__host__ __device__ __forceinline__ int perm32(int rho) { const int n = rho >> 4, i = rho & 15; return 8 * (i >> 2) + 4 * n + (i & 3); }

template <bool SW>
__device__ __forceinline__ void cv_item(const float* src, int Nsrc, int srccol, bf16* dst, int Kd, int prow0, int ks0, int kd0, LAS float* scr, int lane, const float* shift, float* sw) {
#pragma unroll 8
    for (int i = 0; i < 32; ++i) { const int kk = 2 * i + (lane >> 5); scr[kk * 33 + (lane & 31)] = src[(size_t)(ks0 + kk) * Nsrc + srccol]; }
    LAS float* sh = scr + 64 * 33;
    if (SW) {
#pragma unroll
        for (int i = 0; i < 8; ++i) sh[i * 64 + lane] = shift[(size_t)i * NADA + ks0 + lane];
    }
    asm volatile("s_waitcnt lgkmcnt(0)" ::: "memory");
    const int c = lane & 7;
#pragma unroll
    for (int j = 0; j < 4; ++j) { const int n = (lane >> 3) + 8 * j; const LAS float* sp = scr + (8 * c) * 33 + n;
        u32x4 o; o.x = pk2(sp[0 * 33], sp[1 * 33]); o.y = pk2(sp[2 * 33], sp[3 * 33]); o.z = pk2(sp[4 * 33], sp[5 * 33]); o.w = pk2(sp[6 * 33], sp[7 * 33]);
        *(u32x4*)(dst + (size_t)(prow0 + n) * Kd + kd0 + 8 * c) = o; }
    if (SW) {
        const int n = lane & 31, bh = lane >> 5; float acc[4] = {0.f, 0.f, 0.f, 0.f};
#pragma unroll 4
        for (int k4 = 0; k4 < 16; ++k4) { const float t0 = scr[(4 * k4) * 33 + n], t1 = scr[(4 * k4 + 1) * 33 + n], t2 = scr[(4 * k4 + 2) * 33 + n], t3 = scr[(4 * k4 + 3) * 33 + n];
#pragma unroll
            for (int b4 = 0; b4 < 4; ++b4) { const f32x4 sv = *(const LAS f32x4*)(sh + (bh * 4 + b4) * 64 + 4 * k4); acc[b4] += (t0 * sv.x + t1 * sv.y) + (t2 * sv.z + t3 * sv.w); } }
#pragma unroll
        for (int b4 = 0; b4 < 4; ++b4) atomicAdd(sw + (size_t)(bh * 4 + b4) * DIN + prow0 + n, acc[b4]);
    }
    asm volatile("s_waitcnt lgkmcnt(0)" ::: "memory");
}
__device__ __forceinline__ void ph_convert(Frame& F, int l) {
    LAS float* scr = (LAS float*)(F.lds + F.wave * 16384);
    const int gw = F.wg * (NTHREADS / 64) + F.wave, NGW = F.G * (NTHREADS / 64);
    unsigned char* wb = F.ws + WS_W;
    constexpr int I_GU = 16 * 176, I_D = 44 * 32, I_IN = 16 * 176, I_B0 = 4 * 32, I_B1 = 2 * 32, I_B2 = 6 * 32, I_O = 16 * 32;
    constexpr int NIT = 2 * I_GU + 2 * I_D + I_IN + I_B0 + I_B1 + I_B2 + I_O;
    const int r = F.lane & 31;
    const float* shl = F.mod + (size_t)l * BATCH * NADA;
    float* swl = F.SW + (size_t)l * 3 * BATCH * DIN;
    for (int it = gw; it < NIT; it += NGW) {
        int x = it;
        if (x < 2 * I_GU) { const int f = x / I_GU; x %= I_GU; const int kb = x / 176, nb = x % 176, p0 = nb * 32, t = p0 >> 8, bj = (p0 >> 7) & 1, wc = (p0 >> 5) & 3;
            const float* src = F.in[bj ? I_WU : I_WG] + (size_t)(l * 2 + f) * D * DFF;
            cv_item<true>(src, DFF, 128 * t + 32 * wc + perm32(r), (bf16*)(wb + (f ? WO_GU1 : WO_GU0)), D, p0, kb * 64, kb * 64, scr, F.lane, shl + (f ? 6 : 0) * D, swl + (f ? 2 : 0) * BATCH * DIN); continue; }
        x -= 2 * I_GU;
        if (x < I_IN) { const int kb = x / 176, nb = x % 176;
            cv_item<true>(F.in[I_WIN] + (size_t)l * D * DIN, DIN, nb * 32 + perm32(r), (bf16*)(wb + WO_IN), D, nb * 32, kb * 64, kb * 64, scr, F.lane, shl + 3 * D, swl + BATCH * DIN); continue; }
        x -= I_IN;
        if (x < 2 * I_D) { const int f = x / I_D; x %= I_D; const int kb = x / 32, nb = x % 32;
            cv_item<false>(F.in[I_WD] + (size_t)(l * 2 + f) * DFF * D, D, nb * 32 + r, (bf16*)(wb + (f ? WO_D1 : WO_D0)), DFF, nb * 32, kb * 64, kb * 64, scr, F.lane, nullptr, nullptr); continue; }
        x -= 2 * I_D;
        if (x < I_B0) { const int kb = x / 32, nb = x % 32;
            cv_item<false>(F.in[I_WBSB] + (size_t)l * 256 * D, D, nb * 32 + perm32(r), (bf16*)(wb + WO_BR), OC, nb * 32, kb * 64, kb * 64, scr, F.lane, nullptr, nullptr); continue; }
        x -= I_B0;
        if (x < I_B1) { const int kb = x / 32, nb = x % 32;
            cv_item<false>(F.in[I_WBDIL] + (size_t)l * 128 * D, D, nb * 32 + perm32(r), (bf16*)(wb + WO_BR), OC, nb * 32, kb * 64, 256 + kb * 64, scr, F.lane, nullptr, nullptr); continue; }
        x -= I_B1;
        if (x < I_B2) { const int kb = x / 32, nb = x % 32;
            cv_item<false>(F.in[I_WBSWA] + (size_t)l * 384 * D, D, nb * 32 + perm32(r), (bf16*)(wb + WO_BR), OC, nb * 32, kb * 64, 384 + kb * 64, scr, F.lane, nullptr, nullptr); continue; }
        x -= I_B2;
        { const int kb = x / 32, nb = x % 32;
            cv_item<false>(F.in[I_WOUT] + (size_t)l * D * D, D, nb * 32 + r, (bf16*)(wb + WO_OUT), D, nb * 32, kb * 64, kb * 64, scr, F.lane, nullptr, nullptr); }
    }
}

namespace pg8 {
typedef short bf16x8 __attribute__((ext_vector_type(8)));
constexpr int BM = 256, BK = 64, HALF = 128, HTB = HALF * BK * 2, STAGE_BYTES = 8 * HTB, NXCD = 8, WGM = 8;
__host__ __device__ __forceinline__ int lds_byte(int r, int c) { const int st = (r >> 4) * 2 + (c >> 5), rr = r & 15, cc = c & 31, ob = rr * 64 + cc * 2; return st * 1024 + (ob ^ (((ob >> 9) & 1) << 5)); }
__host__ __device__ __forceinline__ void stage_rc(int b, int& R, int& C) { const int st = b / 1024, sb = b % 1024, swz = sb ^ (((sb >> 9) & 1) << 5); R = (st >> 1) * 16 + swz / 64; C = (st & 1) * 32 + (swz % 64) / 2; }
struct Unit { int pm, pn, br; };
struct Gemm { const bf16* A; const bf16* Bt; int ld; };
template <int NBR> struct StaticOrderT {
    int nM, nN, nwg, G, c;
    __device__ void init(int M_, int N_, int G_, int c_) { nM = M_ / BM; nN = N_ / BM; nwg = nM * nN; G = G_; c = c_; }
    __device__ bool next(int i, Unit& u) const {
        const long L = (long)(i / NBR) * G + c; if (L >= nwg) return false;
        int wgid = (int)L; { const int q = nwg / NXCD, r = nwg % NXCD, xcd = wgid % NXCD, off = wgid / NXCD; wgid = (xcd < r ? xcd * (q + 1) : r * (q + 1) + (xcd - r) * q) + off; }
        const int nig = WGM * nN, gid = wgid / nig, fm = gid * WGM, gsz = (nM - fm) < WGM ? (nM - fm) : WGM;
        u.pm = fm + ((wgid % nig) % gsz); u.pn = (wgid % nig) / gsz; u.br = i % NBR; return true;
    }
};
struct OrderK : StaticOrderT<1> {
    int ntiles;
    __device__ __forceinline__ int nt(const Unit&) const { return ntiles; }
    __device__ __forceinline__ int kofs(const Unit&) const { return 0; }
};
struct OrderBr : StaticOrderT<3> {
    __device__ __forceinline__ int nt(const Unit& u) const { return u.br == 0 ? 4 : (u.br == 1 ? 2 : 6); }
    __device__ __forceinline__ int kofs(const Unit& u) const { return u.br == 0 ? 0 : (u.br == 1 ? 256 : 384); }
};

template <class Epi, class Sched, bool ALIGN_EPI, bool SP2>
__device__ __forceinline__ void gemm_phase(LAS unsigned char* lds, const Gemm g, const Sched& S, const Epi& E) {
    const int tid = threadIdx.x, wid = __builtin_amdgcn_readfirstlane(tid >> 6), lane = tid & 63, wr = wid >> 2, wc = wid & 3, fr = lane & 15, fq = lane >> 4;
    const int LD = g.ld;
    unsigned voff[2];
#pragma unroll
    for (int i = 0; i < 2; ++i) { int R, C; stage_rc(tid * 16 + i * 8192, R, C); voff[i] = (unsigned)(R * LD + C) * 2u; }
    const size_t kstep = (size_t)(BK * 2);
    const size_t hstep = (size_t)HALF * LD * 2;
    const size_t tstep = 2 * hstep;
    const unsigned ldsw = (unsigned)wid * 1024u;
    const int aoff = lds_byte(wr * 64 + fr, fq * 8), boff = lds_byte(wc * 32 + fr, fq * 8);
#define PG8_SA(b, h) (((b) * 2 + (h)) * HTB)
#define PG8_SB(b, h) ((4 + (b) * 2 + (h)) * HTB)
#define PG8_STAGE(bufoff, gbase) do { _Pragma("unroll") for (int _i = 0; _i < 2; ++_i) \
        __builtin_amdgcn_global_load_lds((const unsigned*)((const char*)(gbase) + voff[_i]), (LAS unsigned*)(lds + (bufoff) + ldsw + _i * 8192), 16, 0, 0); } while (0)
#define PG8_LDA(dst, b, h) do { _Pragma("unroll") for (int m = 0; m < 4; ++m) _Pragma("unroll") for (int k = 0; k < 2; ++k) dst[m][k] = *(const LAS bf16x8*)(lds + PG8_SA(b, h) + aoff + m * 2048 + k * 1024); } while (0)
#define PG8_LDB(dst, b, h) do { _Pragma("unroll") for (int n = 0; n < 2; ++n) _Pragma("unroll") for (int k = 0; k < 2; ++k) dst[n][k] = *(const LAS bf16x8*)(lds + PG8_SB(b, h) + boff + n * 2048 + k * 1024); } while (0)
#define PG8_MMA(ai, bj, At, Bt) do { __builtin_amdgcn_s_setprio(1); _Pragma("unroll") for (int m = 0; m < 4; ++m) _Pragma("unroll") for (int n = 0; n < 2; ++n) _Pragma("unroll") for (int k = 0; k < 2; ++k) \
        acc[ai][bj][m][n] = __builtin_amdgcn_mfma_f32_16x16x32_bf16(Bt[n][k], At[m][k], acc[ai][bj][m][n], 0, 0, 0); __builtin_amdgcn_s_setprio(0); } while (0)
#define PG8_WAIT_V(n) asm volatile("s_waitcnt vmcnt(" #n ")" ::: "memory")
#define PG8_WAIT_L(n) asm volatile("s_waitcnt lgkmcnt(" #n ")" ::: "memory")
#define PG8_BAR __builtin_amdgcn_s_barrier()
#define PG8_SCHED __builtin_amdgcn_sched_barrier(0)
#define PG8_ZERO() do { _Pragma("unroll") for (int a_ = 0; a_ < 2; ++a_) _Pragma("unroll") for (int b_ = 0; b_ < 2; ++b_) _Pragma("unroll") for (int m_ = 0; m_ < 4; ++m_) _Pragma("unroll") for (int n_ = 0; n_ < 2; ++n_) acc[a_][b_][m_][n_] = (f32x4){0.f, 0.f, 0.f, 0.f}; } while (0)
    Unit cur, nxt; int ui = 0;
    if (!S.next(0, cur)) return;
    f32x4 acc[2][2][4][2];
    PG8_ZERO();
    bf16x8 At[4][2], B0[2][2], B1[2][2];
    const char* cA = (const char*)g.A + (size_t)cur.pm * tstep + (size_t)S.kofs(cur) * 2; const char* cB = (const char*)g.Bt + (size_t)cur.pn * tstep + (size_t)S.kofs(cur) * 2;
    if constexpr (SP2) {
        PG8_STAGE(PG8_SB(0, 0), cB); PG8_STAGE(PG8_SB(0, 1), cB + hstep); PG8_STAGE(PG8_SA(0, 0), cA); PG8_STAGE(PG8_SA(0, 1), cA + hstep);
        if (wr == 1) PG8_BAR;
        PG8_WAIT_V(2); PG8_BAR;
        PG8_STAGE(PG8_SB(1, 0), cB + kstep); PG8_STAGE(PG8_SA(1, 0), cA + kstep); PG8_STAGE(PG8_SB(1, 1), cB + hstep + kstep);
        PG8_WAIT_V(6); PG8_BAR;
    } else {
        PG8_STAGE(PG8_SB(0, 0), cB); PG8_STAGE(PG8_SA(0, 0), cA); PG8_STAGE(PG8_SB(0, 1), cB + hstep); PG8_STAGE(PG8_SA(0, 1), cA + hstep);
        if (wr == 1) PG8_BAR;
        PG8_WAIT_V(4); PG8_BAR;
        PG8_STAGE(PG8_SB(1, 0), cB + kstep); PG8_STAGE(PG8_SA(1, 0), cA + kstep); PG8_STAGE(PG8_SB(1, 1), cB + hstep + kstep);
        PG8_WAIT_V(6); PG8_BAR;
    }
    for (;;) {
        const bool has_next = S.next(ui + 1, nxt);
        const char* nA = has_next ? (const char*)g.A + (size_t)nxt.pm * tstep + (size_t)S.kofs(nxt) * 2 : cA; const char* nB = has_next ? (const char*)g.Bt + (size_t)nxt.pn * tstep + (size_t)S.kofs(nxt) * 2 : cB;
        const int nt = S.nt(cur);
        for (int t = 0; t < nt; t += 2) {
            const bool last = (t == nt - 2);
            const char* a1 = cA + (size_t)(t + 1) * kstep;
            const char* a2 = last ? nA : cA + (size_t)(t + 2) * kstep; const char* b2 = last ? nB : cB + (size_t)(t + 2) * kstep;
            const char* a3 = a2 + kstep; const char* b3 = b2 + kstep;
            if constexpr (SP2) {
            PG8_LDB(B0, 0, 0); PG8_LDB(B1, 0, 1); PG8_SCHED; PG8_LDA(At, 0, 0); PG8_STAGE(PG8_SA(1, 1), a1 + hstep);
            PG8_WAIT_V(8); PG8_WAIT_L(0); PG8_BAR; PG8_MMA(0, 0, At, B0); PG8_MMA(0, 1, At, B1); PG8_BAR; PG8_SCHED;
            PG8_LDA(At, 0, 1); PG8_STAGE(PG8_SB(0, 0), b2); PG8_STAGE(PG8_SB(0, 1), b2 + hstep); PG8_STAGE(PG8_SA(0, 0), a2);
            PG8_WAIT_V(8); PG8_WAIT_L(0); PG8_BAR; PG8_MMA(1, 0, At, B0); PG8_MMA(1, 1, At, B1); PG8_BAR; PG8_SCHED;
            PG8_LDB(B0, 1, 0); PG8_LDB(B1, 1, 1); PG8_SCHED; PG8_LDA(At, 1, 0); PG8_STAGE(PG8_SA(0, 1), a2 + hstep);
            PG8_WAIT_V(8); PG8_WAIT_L(0); PG8_BAR; PG8_MMA(0, 0, At, B0); PG8_MMA(0, 1, At, B1); PG8_BAR; PG8_SCHED;
            PG8_LDA(At, 1, 1); PG8_STAGE(PG8_SB(1, 0), b3); PG8_STAGE(PG8_SB(1, 1), b3 + hstep); PG8_STAGE(PG8_SA(1, 0), a3);
            PG8_WAIT_V(8); PG8_WAIT_L(0); PG8_BAR; PG8_MMA(1, 0, At, B0); PG8_MMA(1, 1, At, B1); PG8_BAR; PG8_SCHED;
            } else {
            PG8_LDB(B0, 0, 0); PG8_SCHED; PG8_LDA(At, 0, 0); PG8_STAGE(PG8_SA(1, 1), a1 + hstep);
            PG8_WAIT_L(8); PG8_BAR; PG8_WAIT_L(0); PG8_MMA(0, 0, At, B0); PG8_BAR; PG8_SCHED;
            PG8_LDB(B1, 0, 1); PG8_STAGE(PG8_SB(0, 0), b2);
            PG8_BAR; PG8_WAIT_L(0); PG8_MMA(0, 1, At, B1); PG8_BAR;
            PG8_LDA(At, 0, 1); PG8_STAGE(PG8_SA(0, 0), a2);
            PG8_BAR; PG8_WAIT_L(0); PG8_MMA(1, 0, At, B0); PG8_BAR; PG8_SCHED;
            PG8_STAGE(PG8_SB(0, 1), b2 + hstep);
            PG8_WAIT_V(6); PG8_BAR; PG8_MMA(1, 1, At, B1); PG8_BAR;
            PG8_LDB(B0, 1, 0); PG8_SCHED; PG8_LDA(At, 1, 0); PG8_STAGE(PG8_SA(0, 1), a2 + hstep);
            PG8_WAIT_L(8); PG8_BAR; PG8_WAIT_L(0); PG8_MMA(0, 0, At, B0); PG8_BAR; PG8_SCHED;
            PG8_LDB(B1, 1, 1); PG8_STAGE(PG8_SB(1, 0), b3);
            PG8_BAR; PG8_WAIT_L(0); PG8_MMA(0, 1, At, B1); PG8_BAR;
            PG8_LDA(At, 1, 1); PG8_STAGE(PG8_SA(1, 0), a3);
            PG8_BAR; PG8_WAIT_L(0); PG8_MMA(1, 0, At, B0); PG8_BAR; PG8_SCHED;
            PG8_STAGE(PG8_SB(1, 1), b3 + hstep);
            PG8_WAIT_V(6); PG8_BAR; PG8_MMA(1, 1, At, B1); PG8_BAR;
            }
        }
        if constexpr (ALIGN_EPI) { if (wr == 0) PG8_BAR; }
        const bool keep = E(acc, cur, wr, wc, fr, fq);
        if (!has_next) break;
        if (!keep) PG8_ZERO();
        cur = nxt; cA = nA; cB = nB; ++ui;
        if constexpr (ALIGN_EPI) { if (wr == 1) PG8_BAR; }
    }
    PG8_WAIT_V(0);
    if constexpr (!ALIGN_EPI) { if (wr == 0) PG8_BAR; }
    PG8_BAR;
#undef PG8_SA
#undef PG8_SB
#undef PG8_STAGE
#undef PG8_LDA
#undef PG8_LDB
#undef PG8_MMA
#undef PG8_WAIT_V
#undef PG8_WAIT_L
#undef PG8_BAR
#undef PG8_SCHED
#undef PG8_ZERO
}

template <bool NEXT, bool HALFCS> struct EpiXupd {
    const float* xin; float* xout; const float* gate0;
    bf16* hout; const float* ng; const float* nscale0; float* ss;
    __device__ __forceinline__ bool operator()(f32x4 (&acc)[2][2][4][2], const Unit& u, int wr, int wc, int fr, int fq) const {
        const float* const xin = this->xin; float* const xout = this->xout; const float* const gate0 = this->gate0; constexpr float cs = HALFCS ? 0.5f : 1.0f;
        bf16* const hout = this->hout; const float* const ng = this->ng; const float* const nscale0 = this->nscale0; float* const ss = this->ss;
        const int row0 = u.pm * BM + wr * 64 + fr, col0 = u.pn * BM + wc * 32 + 4 * fq; const int b = u.pm >> 3;
        const float* gp = gate0 + (size_t)b * NADA + col0;
        f32x4 cv[2][2], gs[2][2];
#pragma unroll
        for (int bj = 0; bj < 2; ++bj)
#pragma unroll
            for (int n = 0; n < 2; ++n) { cv[bj][n] = *(const f32x4*)(gp + bj * HALF + n * 16) * cs;
                if (NEXT) gs[bj][n] = *(const f32x4*)(ng + col0 + bj * HALF + n * 16) * (1.0f + *(const f32x4*)(nscale0 + (size_t)b * NADA + col0 + bj * HALF + n * 16)); }
#pragma unroll
        for (int ai = 0; ai < 2; ++ai)
#pragma unroll
            for (int m = 0; m < 4; ++m) { const int row = row0 + ai * HALF + m * 16; const size_t off = (size_t)row * D + col0; float sq = 0.f;
#pragma unroll
                for (int bj = 0; bj < 2; ++bj)
#pragma unroll
                    for (int n = 0; n < 2; ++n) { const f32x4 xv = *(const f32x4*)(xin + off + bj * HALF + n * 16); const f32x4 xn = xv + cv[bj][n] * acc[ai][bj][m][n];
                        *(f32x4*)(xout + off + bj * HALF + n * 16) = xn;
                        if (NEXT) { sq += (xn.x * xn.x + xn.y * xn.y) + (xn.z * xn.z + xn.w * xn.w); const f32x4 hv = xn * gs[bj][n];
                            u32x2 w; w.x = pk2(hv.x, hv.y); w.y = pk2(hv.z, hv.w); *(u32x2*)(hout + off + bj * HALF + n * 16) = w; } }
                if (NEXT) { sq += __shfl_xor(sq, 16); sq += __shfl_xor(sq, 32); if (fq == 0) atomicAdd(ss + row, sq); } }
        return false;
    }
};
struct EpiSwiglu {
    bf16* act; const float* ss; const float* sw0;
    __device__ __forceinline__ bool operator()(f32x4 (&acc)[2][2][4][2], const Unit& u, int wr, int wc, int fr, int fq) const {
        const int row0 = u.pm * BM + wr * 64 + fr, col0 = u.pn * HALF + wc * 32 + 8 * fq;
        const float* sp = sw0 + (size_t)(u.pm >> 3) * DIN + u.pn * BM + wc * 32 + 4 * fq;
        f32x4 sv[2][2];
#pragma unroll
        for (int bj = 0; bj < 2; ++bj)
#pragma unroll
            for (int n = 0; n < 2; ++n) sv[bj][n] = *(const f32x4*)(sp + bj * HALF + n * 16);
#pragma unroll
        for (int ai = 0; ai < 2; ++ai)
#pragma unroll
            for (int m = 0; m < 4; ++m) {
                const int row = row0 + ai * HALF + m * 16; const float rs = __builtin_amdgcn_rsqf(ss[row] * (1.0f / D) + RMS_EPS);
                const f32x4 g0 = acc[ai][0][m][0] * rs + sv[0][0], g1 = acc[ai][0][m][1] * rs + sv[0][1], u0 = acc[ai][1][m][0] * rs + sv[1][0], u1 = acc[ai][1][m][1] * rs + sv[1][1];
                u32x4 w;
                w.x = pk2(silu_f(g0[0]) * u0[0], silu_f(g0[1]) * u0[1]); w.y = pk2(silu_f(g0[2]) * u0[2], silu_f(g0[3]) * u0[3]);
                w.z = pk2(silu_f(g1[0]) * u1[0], silu_f(g1[1]) * u1[1]); w.w = pk2(silu_f(g1[2]) * u1[2], silu_f(g1[3]) * u1[3]);
                *(u32x4*)(act + (size_t)row * DFF + col0) = w;
            }
        return false;
    }
};
struct EpiQkvg {
    bf16* out; const float* ss; const float* sw0;
    __device__ __forceinline__ bool operator()(f32x4 (&acc)[2][2][4][2], const Unit& u, int wr, int wc, int fr, int fq) const {
        const int row0 = u.pm * BM + wr * 64 + fr;
        const float* sp = sw0 + (size_t)(u.pm >> 3) * DIN + u.pn * BM + wc * 32 + 4 * fq;
        float rs[2][4];
#pragma unroll
        for (int ai = 0; ai < 2; ++ai)
#pragma unroll
            for (int m = 0; m < 4; ++m) rs[ai][m] = __builtin_amdgcn_rsqf(ss[row0 + ai * HALF + m * 16] * (1.0f / D) + RMS_EPS);
#pragma unroll
        for (int bj = 0; bj < 2; ++bj) {
            const int c = u.pn * BM + bj * HALF;
            const bool isq = (c < C_KSB) || (c >= C_QDIL && c < C_KDIL) || (c >= C_QSWA && c < C_KSWA), isg = c >= C_GATE;
            const int col0 = c + wc * 32 + 8 * fq;
            const f32x4 s0 = *(const f32x4*)(sp + bj * HALF), s1 = *(const f32x4*)(sp + bj * HALF + 16);
#pragma unroll
            for (int ai = 0; ai < 2; ++ai)
#pragma unroll
                for (int m = 0; m < 4; ++m) {
                    f32x4 v0 = acc[ai][bj][m][0] * rs[ai][m] + s0, v1 = acc[ai][bj][m][1] * rs[ai][m] + s1;
                    if (isq) { v0 = v0 * QSCALE; v1 = v1 * QSCALE; }
                    if (isg) {
#pragma unroll
                        for (int e = 0; e < 4; ++e) { v0[e] = sigm_f(v0[e]); v1[e] = sigm_f(v1[e]); } }
                    u32x4 w; w.x = pk2(v0[0], v0[1]); w.y = pk2(v0[2], v0[3]); w.z = pk2(v1[0], v1[1]); w.w = pk2(v1[2], v1[3]);
                    *(u32x4*)(out + (size_t)(row0 + ai * HALF + m * 16) * DIN + col0) = w;
                }
        }
        return false;
    }
};
struct EpiBranch {
    const bf16* gates;
    bf16* out;
    __device__ __forceinline__ bool operator()(f32x4 (&acc)[2][2][4][2], const Unit& u, int wr, int wc, int fr, int fq) const {
        const int row0 = u.pm * BM + wr * 64 + fr; const int br = u.br;
#pragma unroll
        for (int ai = 0; ai < 2; ++ai)
#pragma unroll
            for (int m = 0; m < 4; ++m)
#pragma unroll
                for (int bj = 0; bj < 2; ++bj) {
                    const int row = row0 + ai * HALF + m * 16, col0 = u.pn * BM + bj * HALF + wc * 32 + 8 * fq;
                    const u32x4 sc = *(const u32x4*)(gates + (size_t)row * DIN + br * D + col0);
                    float f[8] = {bf2f(sc.x & 0xffffu), bf2f(sc.x >> 16), bf2f(sc.y & 0xffffu), bf2f(sc.y >> 16), bf2f(sc.z & 0xffffu), bf2f(sc.z >> 16), bf2f(sc.w & 0xffffu), bf2f(sc.w >> 16)};
                    if (br < 2) {
                        const u32x4 sn = *(const u32x4*)(gates + (size_t)row * DIN + (br + 1) * D + col0);
                        const float d[8] = {bf2f(sn.x & 0xffffu), bf2f(sn.x >> 16), bf2f(sn.y & 0xffffu), bf2f(sn.y >> 16), bf2f(sn.z & 0xffffu), bf2f(sn.z >> 16), bf2f(sn.w & 0xffffu), bf2f(sn.w >> 16)};
#pragma unroll
                        for (int e = 0; e < 8; ++e) f[e] = f[e] * __builtin_amdgcn_rcpf(fmaxf(d[e], 1e-30f));
                    }
                    f32x4 v0 = acc[ai][bj][m][0], v1 = acc[ai][bj][m][1];
                    v0[0] *= f[0]; v0[1] *= f[1]; v0[2] *= f[2]; v0[3] *= f[3]; v1[0] *= f[4]; v1[1] *= f[5]; v1[2] *= f[6]; v1[3] *= f[7];
                    if (br < 2) { acc[ai][bj][m][0] = v0; acc[ai][bj][m][1] = v1; }
                    else { u32x4 w; w.x = pk2(v0[0], v0[1]); w.y = pk2(v0[2], v0[3]); w.z = pk2(v1[0], v1[1]); w.w = pk2(v1[2], v1[3]); *(u32x4*)(out + (size_t)row * D + col0) = w; }
                }
        return br < 2;
    }
};
}

template <bool NEXT, bool HALFCS>
__device__ __forceinline__ void ph_xupd(Frame& F, const bf16* A, int K, const bf16* Bt, const float* xin, float* xout, bf16* hout, int l, int j, int nl, int nj) {
    pg8::Gemm g{A, Bt, K}; pg8::OrderK S; S.init(M, D, F.G, F.wg); S.ntiles = K / 64;
    const float* gate0 = F.mod + (size_t)l * BATCH * NADA + (j * 3 + 2) * D;
    pg8::EpiXupd<NEXT, HALFCS> E{xin, xout, gate0, NEXT ? hout : nullptr, NEXT ? F.in[I_NG] + (nl * 3 + nj) * D : nullptr, NEXT ? F.mod + (size_t)nl * BATCH * NADA + (nj * 3 + 1) * D : nullptr, NEXT ? F.SS + (size_t)(nl * 3 + nj) * M : nullptr};
    pg8::gemm_phase<pg8::EpiXupd<NEXT, HALFCS>, pg8::OrderK, false, true>(F.lds, g, S, E);
}
__device__ __forceinline__ void ph_ffn_up(Frame& F, const bf16* A, const bf16* Bt, int l, int j) {
    pg8::Gemm g{A, Bt, D}; pg8::OrderK S; S.init(M, 2 * DFF, F.G, F.wg); S.ntiles = D / 64;
    pg8::EpiSwiglu E{F.ACT, F.SS + (size_t)(l * 3 + j) * M, F.SW + (size_t)(l * 3 + j) * BATCH * DIN};
    pg8::gemm_phase<pg8::EpiSwiglu, pg8::OrderK, true, true>(F.lds, g, S, E);
}
__device__ __forceinline__ void ph_inproj(Frame& F, int l) {
    pg8::Gemm g{F.H, (const bf16*)(F.ws + WS_W + WO_IN), D}; pg8::OrderK S; S.init(M, DIN, F.G, F.wg); S.ntiles = D / 64;
    pg8::EpiQkvg E{F.QKVG, F.SS + (size_t)(l * 3 + 1) * M, F.SW + (size_t)(l * 3 + 1) * BATCH * DIN};
    pg8::gemm_phase<pg8::EpiQkvg, pg8::OrderK, true, true>(F.lds, g, S, E);
}
__device__ __forceinline__ void ph_branch(Frame& F) {
    pg8::Gemm g{F.OCAT, (const bf16*)(F.ws + WS_W + WO_BR), OC}; pg8::OrderBr S; S.init(M, D, F.G, F.wg);
    pg8::EpiBranch E{F.QKVG + C_GATE, F.H};
    pg8::gemm_phase<pg8::EpiBranch, pg8::OrderBr, true, true>(F.lds, g, S, E);
}

namespace att {
typedef float f32x16 __attribute__((ext_vector_type(16)));
typedef short bf16x8 __attribute__((ext_vector_type(8)));
typedef short s16x4 __attribute__((ext_vector_type(4)));
typedef short v4i16_t __attribute__((ext_vector_type(4)));
constexpr int KP = 144, LW_K = 0, LW_V = 4608, LW_F = 8704, LW_BYTES = 9216, LDS_BTAB = 8 * LW_BYTES, BT_PITCH = 132;
#define ATT_FENCE() asm volatile("" ::: "memory")
__device__ __forceinline__ int crow(int r, int h) { return (r & 3) + 8 * (r >> 2) + 4 * h; }
__device__ __forceinline__ s16x4 vtr(const LAS unsigned char* p) { return __builtin_bit_cast(s16x4, __builtin_amdgcn_ds_read_tr16_b64_v4i16((LAS v4i16_t*)p)); }
__device__ __forceinline__ float swap_other(float x, int hh) { auto rr = __builtin_amdgcn_permlane32_swap(__float_as_uint(x), __float_as_uint(x), false, false); return __uint_as_float(hh ? rr[0] : rr[1]); }

struct KVRegs { u32x4 k[4], v[4]; };
__device__ __forceinline__ void kv_issue(KVRegs& R, const bf16* base, int kcol, int vcol, const int (&tok)[4], int lane) {
#pragma unroll
    for (int i = 0; i < 4; ++i) { const bf16* pr = base + (size_t)tok[i] * DIN + (lane & 7) * 8; R.k[i] = *(const u32x4*)(pr + kcol); R.v[i] = *(const u32x4*)(pr + vcol); }
}
__device__ __forceinline__ void kv_write(LAS unsigned char* wl, const KVRegs& R, int lane) {
    const int row = lane >> 3, ch = lane & 7;
    ATT_FENCE();
#pragma unroll
    for (int i = 0; i < 4; ++i) { *(LAS u32x4*)(wl + LW_K + (row + 8 * i) * KP + ch * 16) = R.k[i]; *(LAS u32x4*)(wl + LW_V + (ch >> 2) * 2048 + (row + 8 * i) * 64 + (ch & 3) * 16) = R.v[i]; }
    ATT_FENCE();
}
__device__ __forceinline__ f32x16 qk_tile(const LAS unsigned char* wl, const bf16x8 (&qf)[4], int lane) {
    const LAS unsigned char* kp = wl + LW_K + (lane & 31) * KP + (lane >> 5) * 16;
    f32x16 S = {};
#pragma unroll
    for (int d0 = 0; d0 < 4; ++d0) { const bf16x8 kf = *(const LAS bf16x8*)(kp + d0 * 32); S = __builtin_amdgcn_mfma_f32_32x32x16_bf16(kf, qf[d0], S, 0, 0, 0); }
    return S;
}
__device__ __forceinline__ void pv_tile(const LAS unsigned char* wl, const float (&w)[16], f32x16& o0, f32x16& o1, int lane) {
    const int hh = lane >> 5;
    const LAS unsigned char* vp = wl + LW_V + ((lane >> 4) & 1) * 32 + (lane & 3) * 8 + (4 * hh + ((lane & 15) >> 2)) * 64;
#pragma unroll
    for (int s2 = 0; s2 < 2; ++s2) {
        u32x4 pw; pw.x = pk2(w[8 * s2 + 0], w[8 * s2 + 1]); pw.y = pk2(w[8 * s2 + 2], w[8 * s2 + 3]); pw.z = pk2(w[8 * s2 + 4], w[8 * s2 + 5]); pw.w = pk2(w[8 * s2 + 6], w[8 * s2 + 7]);
        const bf16x8 pa = __builtin_bit_cast(bf16x8, pw);
#pragma unroll
        for (int dh = 0; dh < 2; ++dh) {
            const s16x4 lo = vtr(vp + dh * 2048 + s2 * 1024), hi = vtr(vp + dh * 2048 + s2 * 1024 + 512);
            const bf16x8 vf = {lo[0], lo[1], lo[2], lo[3], hi[0], hi[1], hi[2], hi[3]};
            if (dh == 0) o0 = __builtin_amdgcn_mfma_f32_32x32x16_bf16(pa, vf, o0, 0, 0, 0); else o1 = __builtin_amdgcn_mfma_f32_32x32x16_bf16(pa, vf, o1, 0, 0, 0);
        }
    }
}
__device__ __forceinline__ void store_o(LAS unsigned char* wl, const f32x16& o0, const f32x16& o1, float qscale, bf16* dst, const int (&qtok)[4], int lane) {
    const int r = lane & 31, hh = lane >> 5;
    LAS float* fs = (LAS float*)(wl + LW_F); LAS unsigned short* stg = (LAS unsigned short*)(wl + LW_K);
    ATT_FENCE();
    if (hh == 0) fs[r] = qscale;
    ATT_FENCE();
#pragma unroll
    for (int gi = 0; gi < 4; ++gi) { const f32x4 sc = *(const LAS f32x4*)(fs + 8 * gi + 4 * hh);
#pragma unroll
        for (int e = 0; e < 4; ++e) { const int q = 8 * gi + 4 * hh + e; stg[q * 64 + r] = (unsigned short)f2bf(o0[4 * gi + e] * sc[e]); stg[q * 64 + 32 + r] = (unsigned short)f2bf(o1[4 * gi + e] * sc[e]); } }
    ATT_FENCE();
#pragma unroll
    for (int i = 0; i < 4; ++i) { const int row = (lane >> 3) + 8 * i; const u32x4 v = *(const LAS u32x4*)(stg + row * 64 + (lane & 7) * 8); *(u32x4*)(dst + (size_t)qtok[i] * OC + (lane & 7) * 8) = v; }
    ATT_FENCE();
}

__device__ __forceinline__ void sb_item(const bf16* qkvg, bf16* ocat, int b, int h, int qt, LAS unsigned char* wl, int lane) {
    const int r = lane & 31, hh = lane >> 5; const bf16* base = qkvg + (size_t)b * SEQ * DIN;
    bf16x8 qf[4];
#pragma unroll
    for (int d0 = 0; d0 < 4; ++d0) qf[d0] = *(const bf16x8*)(base + (size_t)(qt * 32 + r) * DIN + C_QSB + h * HD + 16 * d0 + 8 * hh);
    f32x16 o0 = {}, o1 = {}; float carry = 1.0f;
    for (int kt = qt; kt >= 0; --kt) {
        int tok[4];
#pragma unroll
        for (int i = 0; i < 4; ++i) tok[i] = kt * 32 + (lane >> 3) + 8 * i;
        KVRegs R; kv_issue(R, base, C_KSB + h * HD, C_VSB + h * HD, tok, lane); kv_write(wl, R, lane);
        const f32x16 S = qk_tile(wl, qf, lane);
        float f[16], be[16];
#pragma unroll
        for (int g = 0; g < 16; ++g) { const float e = __builtin_amdgcn_exp2f(fminf(S[g], 80.f)); const float fr = __builtin_amdgcn_rcpf(1.0f + e); f[g] = fr; be[g] = e * fr; }
        if (kt == qt) {
#pragma unroll
            for (int g = 0; g < 16; ++g) { const bool valid = crow(g, hh) < r; f[g] = valid ? f[g] : 1.0f; be[g] = valid ? be[g] : 0.0f; }
        }
        float X[16], T0[4], T1[4];
#pragma unroll
        for (int gi = 0; gi < 4; ++gi) { const float L3 = f[4 * gi + 3], L2 = f[4 * gi + 2] * L3, L1 = f[4 * gi + 1] * L2, L0 = f[4 * gi] * L1;
            X[4 * gi + 3] = 1.0f; X[4 * gi + 2] = L3; X[4 * gi + 1] = L2; X[4 * gi] = L1;
            auto rr = __builtin_amdgcn_permlane32_swap(__float_as_uint(L0), __float_as_uint(L0), false, false); T0[gi] = __uint_as_float(rr[0]); T1[gi] = __uint_as_float(rr[1]); }
        float E[4]; E[3] = carry; E[2] = E[3] * (T0[3] * T1[3]); E[1] = E[2] * (T0[2] * T1[2]); E[0] = E[1] * (T0[1] * T1[1]); carry = E[0] * (T0[0] * T1[0]);
        float w[16];
#pragma unroll
        for (int g = 0; g < 16; ++g) { const float eg = hh ? E[g >> 2] : E[g >> 2] * T1[g >> 2]; w[g] = be[g] * (eg * X[g]); }
        pv_tile(wl, w, o0, o1, lane);
        if (__all(carry < 1.2e-38f)) break;
    }
    int qtok[4];
#pragma unroll
    for (int i = 0; i < 4; ++i) qtok[i] = qt * 32 + (lane >> 3) + 8 * i;
    store_o(wl, o0, o1, 1.0f, ocat + (size_t)b * SEQ * OC + h * HD, qtok, lane);
}

struct BandState { float m, l; f32x16 o0, o1; };
__device__ __forceinline__ void band_group(BandState& st, const bf16* base, int qtok, int qcol, int kcol, int vcol, int d, int sstep, int P0, int kres, int NT, int maxd,
                                           const LAS float* bt, LAS unsigned char* wl, int lane) {
    const int r = lane & 31, hh = lane >> 5;
    LAS float* fs = (LAS float*)(wl + LW_F);
    bf16x8 qf[4];
#pragma unroll
    for (int d0 = 0; d0 < 4; ++d0) qf[d0] = *(const bf16x8*)(base + (size_t)qtok * DIN + qcol + 16 * d0 + 8 * hh);
    for (int c = 0; c < NT; ++c) {
        const int idx0 = P0 - 128 + 32 * c;
        if (idx0 + 31 < 0) continue;
        int tok[4];
#pragma unroll
        for (int i = 0; i < 4; ++i) { const int ix = idx0 + (lane >> 3) + 8 * i; const int tk = kres + d * (ix < 0 ? 0 : ix); tok[i] = tk > SEQ - 1 ? SEQ - 1 : tk; }
        KVRegs R; kv_issue(R, base, kcol, vcol, tok, lane); kv_write(wl, R, lane);
        const f32x16 S = qk_tile(wl, qf, lane);
        float sc[16]; bool valid[16]; float mx = -1e30f;
#pragma unroll
        for (int g = 0; g < 16; ++g) { const int k = crow(g, hh), rel = sstep * r + 128 - 32 * c - k; valid[g] = (rel >= 0) && (rel <= maxd) && (idx0 + k >= 0);
            const int ri = rel < 0 ? 0 : (rel > 128 ? 128 : rel); sc[g] = S[g] + bt[ri]; mx = fmaxf(mx, valid[g] ? sc[g] : -1e30f); }
        mx = fmaxf(mx, swap_other(mx, hh));
        if (__any(mx > st.m + 8.0f)) {
            const float mn = fmaxf(st.m, mx), fsc = __builtin_amdgcn_exp2f(st.m - mn); st.l *= fsc; st.m = mn;
            ATT_FENCE(); if (hh == 0) fs[r] = fsc; ATT_FENCE();
#pragma unroll
            for (int gi = 0; gi < 4; ++gi) { const f32x4 fv = *(const LAS f32x4*)(fs + 8 * gi + 4 * hh);
#pragma unroll
                for (int e = 0; e < 4; ++e) { st.o0[4 * gi + e] *= fv[e]; st.o1[4 * gi + e] *= fv[e]; } }
            ATT_FENCE();
        }
        float w[16]; float ls = 0.f;
#pragma unroll
        for (int g = 0; g < 16; ++g) { w[g] = valid[g] ? __builtin_amdgcn_exp2f(sc[g] - st.m) : 0.0f; ls += w[g]; }
        st.l += ls;
        pv_tile(wl, w, st.o0, st.o1, lane);
    }
}
}

__device__ __forceinline__ void ph_attn(Frame& F, int l) {
    using namespace att;
    LAS float* btab = (LAS float*)(F.lds + LDS_BTAB);
    const float* relb = F.in[I_RELB];
    for (int idx = F.tid; idx < 12 * 129; idx += NTHREADS) { const int head = idx / 129, rel = idx % 129; const int dd = head < 2 ? 1 : (head < 4 ? 4 : (head < 6 ? 16 : 1));
        btab[head * BT_PITCH + rel] = relb[t5_bucket(rel * dd) * 12 + head] * LOG2E; }
    __syncthreads();
    LAS unsigned char* wl = F.lds + F.wave * LW_BYTES;
    const int lane = F.lane, r = lane & 31, hh = lane >> 5;
    const int gw = F.wg * (NTHREADS / 64) + F.wave, NGW = F.G * (NTHREADS / 64);
    for (int it = gw; it < 1024 + 2048 + 3072; it += NGW) {
        if (it < 1024) {
            const int b = it >> 7, slot = (it >> 6) & 1, r16 = (it >> 2) & 15, i0 = (it & 3) * 32;
            const bf16* base = F.QKVG + (size_t)b * SEQ * DIN; const int qtok = r16 + 16 * (i0 + r);
            BandState st; st.m = -1e30f; st.l = 0.f; st.o0 = f32x16{}; st.o1 = f32x16{};
            band_group(st, base, qtok, C_QDIL + (4 + slot) * HD, C_KDIL + (4 + slot) * HD, C_VDIL + (4 + slot) * HD, 16, 1, i0, r16, 5, 128, btab + (4 + slot) * BT_PITCH, wl, lane);
            band_group(st, base, qtok, C_QDIL + (2 + slot) * HD, C_KDIL + (2 + slot) * HD, C_VDIL + (2 + slot) * HD, 4, 4, (r16 >> 2) + 4 * i0, r16 & 3, 8, 128, btab + (2 + slot) * BT_PITCH, wl, lane);
            band_group(st, base, qtok, C_QDIL + slot * HD, C_KDIL + slot * HD, C_VDIL + slot * HD, 1, 16, r16 + 16 * i0, 0, 20, 128, btab + slot * BT_PITCH, wl, lane);
            const float lt = st.l + swap_other(st.l, hh);
            int qt4[4];
#pragma unroll
            for (int i = 0; i < 4; ++i) qt4[i] = r16 + 16 * (i0 + (lane >> 3) + 8 * i);
            store_o(wl, st.o0, st.o1, 1.0f / lt, F.OCAT + (size_t)b * SEQ * OC + 256 + slot * HD, qt4, lane);
        } else if (it < 3072) {
            const int x = it - 1024, qt = 63 - (x >> 5), b = (x & 31) >> 2, h = x & 3;
            sb_item(F.QKVG, F.OCAT, b, h, qt, wl, lane);
        } else {
            const int x = it - 3072, hq = x % 6, qt = (x / 6) % 64, b = x / 384, kv = hq / 3;
            const bf16* base = F.QKVG + (size_t)b * SEQ * DIN;
            const float sk = F.in[I_SINKS][l * 6 + hq] * LOG2E;
            BandState st; st.m = sk; st.l = 0.f; st.o0 = f32x16{}; st.o1 = f32x16{};
            band_group(st, base, qt * 32 + r, C_QSWA + hq * HD, C_KSWA + kv * HD, C_VSWA + kv * HD, 1, 1, qt * 32, 0, 5, 127, btab + (6 + hq) * BT_PITCH, wl, lane);
            const float lt = st.l + swap_other(st.l, hh) + __builtin_amdgcn_exp2f(sk - st.m);
            int qt4[4];
#pragma unroll
            for (int i = 0; i < 4; ++i) qt4[i] = qt * 32 + (lane >> 3) + 8 * i;
            store_o(wl, st.o0, st.o1, 1.0f / lt, F.OCAT + (size_t)b * SEQ * OC + 384 + hq * HD, qt4, lane);
        }
    }
}

#define XB_TMO      128
#define XB_XCNT(j)  (256  + 64 * (j))
#define XB_XSUB(j)  (1280 + 64 * (j))
#define XB_XGEN(j)  (2304 + 64 * (j))
#define XB_TOP      3328
#define XB_TOPGEN   3392
#define XCD_BAR_WORDS 3456
#define XB_SPIN_CAP (1u << 18)
__device__ __forceinline__ unsigned xb_ld(unsigned* p)              { return __hip_atomic_load(p, __ATOMIC_RELAXED, __HIP_MEMORY_SCOPE_AGENT); }
__device__ __forceinline__ unsigned xb_add(unsigned* p, unsigned v) { return __hip_atomic_fetch_add(p, v, __ATOMIC_RELAXED, __HIP_MEMORY_SCOPE_AGENT); }
__device__ __forceinline__ unsigned xb_xcc_id() { return (unsigned)__builtin_amdgcn_s_getreg((3 << 11) | 20) & 0xFu; }
#define XB_SPIN(cond, bar) do { unsigned _sp = 0; while (cond) { __builtin_amdgcn_s_sleep(1); \
    if ((++_sp & 255u) == 0u) { if (xb_ld(&(bar)[XB_TMO])) break; if (_sp > XB_SPIN_CAP) { atomicAdd(&(bar)[XB_TMO], 1u); break; } } } } while (0)
struct XcdBarrier { unsigned* bar; unsigned x; volatile LAS unsigned* st; };
__device__ __forceinline__ XcdBarrier xcd_barrier_post(unsigned* bar, volatile LAS unsigned* st) {
    XcdBarrier b; b.bar = bar; b.x = xb_xcc_id(); b.st = st;
    if (threadIdx.x == 0) (void)xb_add(&bar[XB_XCNT(b.x)], 1u);
    return b;
}
__device__ __forceinline__ void xcd_barrier_complete(unsigned* bar, unsigned x, unsigned& nloc, unsigned& nx) {
    const unsigned G = gridDim.x * gridDim.y * gridDim.z;
    unsigned sum, cnt, mine, sp = 0u;
    for (;;) {
        sum = 0u; cnt = 0u; mine = 0u;
#pragma unroll
        for (unsigned j = 0; j < 16; ++j) { const unsigned c = xb_ld(&bar[XB_XCNT(j)]); sum += c; cnt += (c > 0u) ? 1u : 0u; mine = (j == x) ? c : mine; }
        if (sum == G) break;
        __builtin_amdgcn_s_sleep(1);
        if ((++sp & 255u) == 0u) { if (xb_ld(&bar[XB_TMO])) break; if (sp > XB_SPIN_CAP) { atomicAdd(&bar[XB_TMO], 1u); break; } }
    }
    nloc = mine > 0u ? mine : 1u; nx = cnt > 0u ? cnt : 1u;
}
__device__ __forceinline__ void xcd_barrier(const XcdBarrier& b) {
    asm volatile("s_waitcnt vmcnt(0)" ::: "memory");
    __syncthreads();
    if (threadIdx.x == 0) {
        unsigned* bar = b.bar;
        __builtin_amdgcn_s_waitcnt(0);
        unsigned nloc = b.st[0], nx = b.st[1];
        if (nloc == 0u) { xcd_barrier_complete(bar, b.x, nloc, nx); b.st[0] = nloc; b.st[1] = nx; }
        const unsigned old = xb_add(&bar[XB_XSUB(b.x)], 1u);
        const unsigned gen = old / nloc;
        if (old + 1u == (gen + 1u) * nloc) {
            __builtin_amdgcn_fence(__ATOMIC_RELEASE, "agent");
            asm volatile("s_waitcnt vmcnt(0)" ::: "memory");
            const unsigned og = xb_add(&bar[XB_TOP], 1u);
            const unsigned tg = og / nx;
            if (og + 1u == (tg + 1u) * nx) xb_add(&bar[XB_TOPGEN], 1u);
            else XB_SPIN(xb_ld(&bar[XB_TOPGEN]) == tg, bar);
            __builtin_amdgcn_fence(__ATOMIC_ACQUIRE, "agent");
            xb_add(&bar[XB_XGEN(b.x)], 1u);
            asm volatile("s_waitcnt vmcnt(0)" ::: "memory");
        } else {
            XB_SPIN(xb_ld(&bar[XB_XGEN(b.x)]) == gen, bar);
            __builtin_amdgcn_fence(__ATOMIC_ACQUIRE, "agent");
            asm volatile("s_waitcnt vmcnt(0)" ::: "memory");
        }
    }
    __syncthreads();
}

#ifndef MK_ONE_LAUNCH
#define MK_ONE_LAUNCH 1
#endif
constexpr int NPHASE = 20;
constexpr int RING_BYTES = 131072, MISC_OFF = RING_BYTES + 320, LDS_BYTES = 147456;
static_assert(XCD_BAR_WORDS * 4 <= (int)WS_MOD && att::LDS_BTAB + 12 * att::BT_PITCH * 4 <= RING_BYTES, "maps");

__global__ void __launch_bounds__(NTHREADS, 2) mk_fwd(Args a) {
    extern __shared__ __attribute__((aligned(16))) unsigned char lds[];
    Frame F;
    F.lds = (LAS unsigned char*)lds; F.tid = threadIdx.x; F.lane = F.tid & 63; F.wave = __builtin_amdgcn_readfirstlane(F.tid >> 6); F.G = gridDim.x; F.wg = blockIdx.x;
#pragma unroll
    for (int i = 0; i < 16; ++i) F.in[i] = a.in[i];
    F.X = a.out; F.ws = a.ws; F.mod = (float*)(a.ws + WS_MOD); F.SS = (float*)(a.ws + WS_SS); F.SW = (float*)(a.ws + WS_SW); F.H = (bf16*)(a.ws + WS_H); F.H2 = (bf16*)(a.ws + WS_H2); F.OCAT = (bf16*)(a.ws + WS_OCAT); F.QKVG = (bf16*)(a.ws + WS_BIG); F.ACT = (bf16*)(a.ws + WS_BIG);
    volatile LAS unsigned* MISC = (volatile LAS unsigned*)(F.lds + MISC_OFF);
    if (F.tid < 32) MISC[F.tid] = 0u;
    __syncthreads();
    const int lo = a.ph_lo, hi = a.ph_hi;
    XcdBarrier bar; bar.bar = (unsigned*)(a.ws + WS_CTL); bar.x = 0; bar.st = nullptr;
    if (hi - lo > 1) bar = xcd_barrier_post((unsigned*)(a.ws + WS_CTL), MISC + 8);
    unsigned char* const wb = a.ws + WS_W;
#define PHASE(k, ...) do { if (lo <= (k) && (k) < hi) { __VA_ARGS__; if ((k) + 1 < hi) xcd_barrier(bar); } } while (0)
#define LAYER(l, XIN0, P) \
    PHASE((P) + 0, ph_ffn_up(F, F.H, (const bf16*)(wb + WO_GU0), (l), 0)); \
    PHASE((P) + 1, ph_xupd<true, true>(F, F.ACT, DFF, (const bf16*)(wb + WO_D0), (XIN0), F.X, F.H, (l), 0, (l), 1)); \
    PHASE((P) + 2, ph_inproj(F, (l))); \
    PHASE((P) + 3, ph_attn(F, (l))); \
    PHASE((P) + 4, ph_branch(F)); \
    PHASE((P) + 5, ph_xupd<true, false>(F, F.H, D, (const bf16*)(wb + WO_OUT), F.X, F.X, F.H2, (l), 1, (l), 2)); \
    PHASE((P) + 6, ph_ffn_up(F, F.H2, (const bf16*)(wb + WO_GU1), (l), 2)); \
    PHASE((P) + 7, ph_xupd<((l) + 1 < DEPTH), true>(F, F.ACT, DFF, (const bf16*)(wb + WO_D1), F.X, F.X, F.H, (l), 2, (l) + 1, 0))
    PHASE(0, ph_adaln(F));
    PHASE(1, ph_convert(F, 0); ph_prep0(F));
    LAYER(0, F.in[I_X], 2);
    PHASE(10, ph_convert(F, 1));
    LAYER(1, F.X, 11);
    PHASE(NPHASE - 1, ph_final(F));
#undef LAYER
#undef PHASE
}

extern "C" void kernel_launch(void* const* d_in, const int* in_sizes, int n_in, void* d_out, int out_size, void* d_ws, size_t ws_size, hipStream_t stream) {
    static int grid = 0;
    if (grid == 0) {
        if (n_in != 16 || in_sizes[0] != M * D || out_size != M * D || ws_size < WS_END) { fprintf(stderr, "kernel_launch: unexpected shapes (n_in %d, in0 %d, out %d, ws %zu)\n", n_in, n_in > 0 ? in_sizes[0] : -1, out_size, ws_size); grid = -1; return; }
        int dev = 0, cus = 0, per_cu = 0;
        if (hipGetDevice(&dev) != hipSuccess || hipDeviceGetAttribute(&cus, hipDeviceAttributeMultiprocessorCount, dev) != hipSuccess) { grid = -1; return; }
        if (hipFuncSetAttribute((const void*)mk_fwd, hipFuncAttributeMaxDynamicSharedMemorySize, LDS_BYTES) != hipSuccess) { fprintf(stderr, "kernel_launch: hipFuncSetAttribute failed\n"); grid = -1; return; }
        if (hipOccupancyMaxActiveBlocksPerMultiprocessor(&per_cu, (const void*)mk_fwd, NTHREADS, LDS_BYTES) != hipSuccess || per_cu < 1) { fprintf(stderr, "kernel_launch: occupancy query reports %d workgroups per CU\n", per_cu); (void)hipGetLastError(); grid = -1; return; }
        grid = cus;
    }
    if (grid < 0) return;
    Args a{};
    for (int i = 0; i < 16; ++i) a.in[i] = (const float*)d_in[i];
    a.out = (float*)d_out; a.ws = (unsigned char*)d_ws;
#if MK_ONE_LAUNCH
    (void)hipMemsetAsync((char*)d_ws + WS_CTL, 0, ZERO_BYTES, stream);
    a.ph_lo = 0; a.ph_hi = NPHASE;
    hipLaunchKernelGGL(mk_fwd, dim3(grid), dim3(NTHREADS), LDS_BYTES, stream, a);
#else
    for (int ph = 0; ph < NPHASE; ++ph) { a.ph_lo = ph; a.ph_hi = ph + 1; hipLaunchKernelGGL(mk_fwd, dim3(grid), dim3(NTHREADS), LDS_BYTES, stream, a); }
#endif
}
```

```cpp
#include <hip/hip_runtime.h>
#include <cstdio>
#include <cstdint>

#define LAS __attribute__((address_space(3)))
typedef unsigned short bf16;
typedef float f32x4 __attribute__((ext_vector_type(4)));
typedef unsigned u32x2 __attribute__((ext_vector_type(2)));
typedef unsigned u32x4 __attribute__((ext_vector_type(4)));

constexpr int D = 1024, BATCH = 8, SEQ = 2048, M = BATCH * SEQ, DEPTH = 2, HD = 64;
constexpr int DFF = 2816, DIN = 5632, NADA = 9216;
constexpr int C_QSB = 0, C_KSB = 256, C_VSB = 512, C_QDIL = 768, C_KDIL = 1152, C_VDIL = 1536, C_QSWA = 1920, C_KSWA = 2304, C_VSWA = 2432, C_GATE = 2560;
constexpr int OC = 768;
constexpr float RMS_EPS = 1e-6f;
constexpr float QSCALE = 0.125f * 1.4426950408889634f;
constexpr float LOG2E = 1.4426950408889634f;
constexpr int NTHREADS = 512;

constexpr size_t MiB = 1u << 20;
constexpr size_t WS_CTL = 0, WS_MOD = 65536, ZERO_BYTES = 655360;
constexpr size_t WS_SS = 1 * MiB, WS_SW = MiB + MiB / 2, WS_SW_END = WS_SW + (size_t)DEPTH * 3 * BATCH * DIN * 4;
constexpr size_t WS_W = 4 * MiB, WS_H = 52 * MiB, WS_OCAT = 84 * MiB, WS_BIG = 108 * MiB, WS_H2 = 284 * MiB, WS_END = 316 * MiB;
static_assert(WS_MOD + (size_t)DEPTH * BATCH * NADA * 4 <= ZERO_BYTES && WS_SS + 7 * (size_t)M * 4 <= WS_SW && WS_SW_END <= WS_W, "ws map");

enum { I_X = 0, I_C, I_WADA, I_BADA, I_NG, I_WG, I_WU, I_WD, I_WIN, I_WBSB, I_WBDIL, I_WBSWA, I_WOUT, I_SINKS, I_RELB, I_FG };

struct Args { const float* in[16]; float* out; unsigned char* ws; int ph_lo, ph_hi; };

__device__ __forceinline__ unsigned f2bf(float f) { unsigned u = __builtin_bit_cast(unsigned, f); return (u + 0x7fffu + ((u >> 16) & 1u)) >> 16; }
__device__ __forceinline__ float bf2f(unsigned b) { return __builtin_bit_cast(float, b << 16); }
typedef float f32x2_t __attribute__((ext_vector_type(2))); typedef __bf16 bf16x2_t __attribute__((ext_vector_type(2)));
__device__ __forceinline__ unsigned pk2(float lo, float hi) { const f32x2_t v = {lo, hi}; const bf16x2_t b = __builtin_convertvector(v, bf16x2_t); return __builtin_bit_cast(unsigned, b); }
__device__ __forceinline__ float wave_sum(float v) {
#pragma unroll
    for (int o = 1; o < 64; o <<= 1) v += __shfl_xor(v, o);
    return v;
}
__device__ __forceinline__ float sigmoidf_(float x) { return 1.0f / (1.0f + __expf(-x)); }

struct Frame {
    LAS unsigned char* lds;
    int tid, lane, wave, G, wg;
    const float* in[16];
    float* X;
    float* mod;
    float* SS;
    float* SW;
    bf16 *H, *H2, *OCAT, *QKVG, *ACT;
    unsigned char* ws;
};

__device__ __forceinline__ const float* modp(const Frame& F, int l, int b, int j, int t) { return F.mod + ((size_t)(l * BATCH + b) * NADA) + (j * 3 + t) * D; }

__device__ __forceinline__ float silu_f(float g) { return g * __builtin_amdgcn_rcpf(1.0f + __expf(-g)); }
__device__ __forceinline__ float sigm_f(float g) { return __builtin_amdgcn_rcpf(1.0f + __expf(-g)); }

__device__ __forceinline__ void ph_adaln(Frame& F) {
    { f32x4* z = (f32x4*)(F.ws + WS_SS); const int nz = (int)((WS_SW_END - WS_SS) / 16); for (int i = F.wg * NTHREADS + F.tid; i < nz; i += F.G * NTHREADS) z[i] = (f32x4){0.f, 0.f, 0.f, 0.f}; }
    LAS float* sc = (LAS float*)F.lds; LAS float* red = sc + 8 * 256;
    const float* c = F.in[I_C]; const float* W = F.in[I_WADA]; const float* bb = F.in[I_BADA];
    for (int it = F.wg; it < DEPTH * 36 * 4; it += F.G) {
        const int kq = it & 3, nb = (it >> 2) % 36, l = it / 144;
        for (int i = F.tid; i < 8 * 256; i += NTHREADS) { const float cv = c[(i >> 8) * D + kq * 256 + (i & 255)]; sc[i] = cv * sigm_f(cv); }
        __syncthreads();
        f32x4 acc[8];
#pragma unroll
        for (int b = 0; b < 8; ++b) acc[b] = (f32x4){0.f, 0.f, 0.f, 0.f};
        const float* wp = W + ((size_t)l * D + kq * 256 + F.wave * 32) * NADA + nb * 256 + 4 * F.lane;
#pragma unroll 4
        for (int kk = 0; kk < 32; ++kk) { const f32x4 wv = *(const f32x4*)(wp + (size_t)kk * NADA);
#pragma unroll
            for (int b = 0; b < 8; ++b) acc[b] += sc[b * 256 + F.wave * 32 + kk] * wv; }
#pragma unroll
        for (int b = 0; b < 8; ++b) *(LAS f32x4*)(red + (F.wave * 8 + b) * 256 + 4 * F.lane) = acc[b];
        __syncthreads();
        { const int b = F.tid >> 6, c4 = (F.tid & 63) * 4; f32x4 sum = (f32x4){0.f, 0.f, 0.f, 0.f};
#pragma unroll
          for (int w = 0; w < 8; ++w) sum += *(const LAS f32x4*)(red + (w * 8 + b) * 256 + c4);
          if (kq == 0) sum += *(const f32x4*)(bb + l * NADA + nb * 256 + c4);
          float* dst = F.mod + (size_t)(l * BATCH + b) * NADA + nb * 256 + c4;
          atomicAdd(dst + 0, sum.x); atomicAdd(dst + 1, sum.y); atomicAdd(dst + 2, sum.z); atomicAdd(dst + 3, sum.w); }
        __syncthreads();
    }
}

__device__ __forceinline__ void ph_prep0(Frame& F) {
    const float* xin = F.in[I_X]; const float* g = F.in[I_NG];
    const int gw = F.wg * (NTHREADS / 64) + F.wave, NGW = F.G * (NTHREADS / 64);
    for (int m = gw; m < M; m += NGW) {
        const int b = m / SEQ; const float* sc = modp(F, 0, b, 0, 1);
        const f32x4* xr = (const f32x4*)(xin + (size_t)m * D) + F.lane;
        f32x4 v[4]; float s = 0.f;
#pragma unroll
        for (int i = 0; i < 4; ++i) { v[i] = xr[64 * i]; s += (v[i].x * v[i].x + v[i].y * v[i].y) + (v[i].z * v[i].z + v[i].w * v[i].w); }
        s = wave_sum(s);
        if (F.lane == 0) F.SS[m] = s;
        u32x2* o = (u32x2*)(F.H + (size_t)m * D) + F.lane;
#pragma unroll
        for (int i = 0; i < 4; ++i) {
            const int c0 = 4 * F.lane + 256 * i; const f32x4 gg = *(const f32x4*)(g + c0), ss = *(const f32x4*)(sc + c0);
            const f32x4 y = v[i] * gg * (1.0f + ss);
            u32x2 w; w.x = pk2(y.x, y.y); w.y = pk2(y.z, y.w); o[64 * i] = w;
        }
    }
}
__device__ __forceinline__ void ph_final(Frame& F) {
    const float* g = F.in[I_FG];
    const int gw = F.wg * (NTHREADS / 64) + F.wave, NGW = F.G * (NTHREADS / 64);
    for (int m = gw; m < M; m += NGW) {
        f32x4* xr = (f32x4*)(F.X + (size_t)m * D) + F.lane;
        f32x4 v[4]; float s = 0.f;
#pragma unroll
        for (int i = 0; i < 4; ++i) { v[i] = xr[64 * i]; s += (v[i].x * v[i].x + v[i].y * v[i].y) + (v[i].z * v[i].z + v[i].w * v[i].w); }
        const float rstd = 1.0f / sqrtf(wave_sum(s) * (1.f / D) + RMS_EPS);
#pragma unroll
        for (int i = 0; i < 4; ++i) { const f32x4 gg = *(const f32x4*)(g + 4 * F.lane + 256 * i); xr[64 * i] = v[i] * rstd * gg; }
    }
}

__device__ __forceinline__ int t5_bucket(int n) {
    if (n < 16) return n;
    int b = 16;
    b += (n >= 22); b += (n >= 30); b += (n >= 40); b += (n >= 54); b += (n >= 73); b += (n >= 99); b += (n >= 134); b += (n >= 182);
    b += (n >= 246); b += (n >= 332); b += (n >= 450); b += (n >= 609); b += (n >= 825); b += (n >= 1117); b += (n >= 1513); b += (n >= 2048);
    return b > 31 ? 31 : b;
}
constexpr size_t WO_GU0 = 0, WO_D0 = 11 * MiB, WO_GU1 = 16 * MiB + MiB / 2, WO_D1 = 27 * MiB + MiB / 2, WO_IN = 33 * MiB, WO_BR = 44 * MiB, WO_OUT = 45 * MiB + MiB / 2;
static_assert(WS_W + WO_OUT + 2 * MiB <= WS_H, "weight copies fit below H");
__host__ __device__ __forceinline__ int perm32(int rho) { const int n = rho >> 4, i = rho & 15; return 8 * (i >> 2) + 4 * n + (i & 3); }

template <bool SW>
__device__ __forceinline__ void cv_item(const float* src, int Nsrc, int srccol, bf16* dst, int Kd, int prow0, int ks0, int kd0, LAS float* scr, int lane, const float* shift, float* sw) {
#pragma unroll 8
    for (int i = 0; i < 32; ++i) { const int kk = 2 * i + (lane >> 5); scr[kk * 33 + (lane & 31)] = src[(size_t)(ks0 + kk) * Nsrc + srccol]; }
    LAS float* sh = scr + 64 * 33;
    if (SW) {
#pragma unroll
        for (int i = 0; i < 8; ++i) sh[i * 64 + lane] = shift[(size_t)i * NADA + ks0 + lane];
    }
    asm volatile("s_waitcnt lgkmcnt(0)" ::: "memory");
    const int c = lane & 7;
#pragma unroll
    for (int j = 0; j < 4; ++j) { const int n = (lane >> 3) + 8 * j; const LAS float* sp = scr + (8 * c) * 33 + n;
        u32x4 o; o.x = pk2(sp[0 * 33], sp[1 * 33]); o.y = pk2(sp[2 * 33], sp[3 * 33]); o.z = pk2(sp[4 * 33], sp[5 * 33]); o.w = pk2(sp[6 * 33], sp[7 * 33]);
        *(u32x4*)(dst + (size_t)(prow0 + n) * Kd + kd0 + 8 * c) = o; }
    if (SW) {
        const int n = lane & 31, bh = lane >> 5; float acc[4] = {0.f, 0.f, 0.f, 0.f};
#pragma unroll 4
        for (int k4 = 0; k4 < 16; ++k4) { const float t0 = scr[(4 * k4) * 33 + n], t1 = scr[(4 * k4 + 1) * 33 + n], t2 = scr[(4 * k4 + 2) * 33 + n], t3 = scr[(4 * k4 + 3) * 33 + n];
#pragma unroll
            for (int b4 = 0; b4 < 4; ++b4) { const f32x4 sv = *(const LAS f32x4*)(sh + (bh * 4 + b4) * 64 + 4 * k4); acc[b4] += (t0 * sv.x + t1 * sv.y) + (t2 * sv.z + t3 * sv.w); } }
#pragma unroll
        for (int b4 = 0; b4 < 4; ++b4) atomicAdd(sw + (size_t)(bh * 4 + b4) * DIN + prow0 + n, acc[b4]);
    }
    asm volatile("s_waitcnt lgkmcnt(0)" ::: "memory");
}
__device__ __forceinline__ void ph_convert(Frame& F, int l) {
    LAS float* scr = (LAS float*)(F.lds + F.wave * 16384);
    const int gw = F.wg * (NTHREADS / 64) + F.wave, NGW = F.G * (NTHREADS / 64);
    unsigned char* wb = F.ws + WS_W;
    constexpr int I_GU = 16 * 176, I_D = 44 * 32, I_IN = 16 * 176, I_B0 = 4 * 32, I_B1 = 2 * 32, I_B2 = 6 * 32, I_O = 16 * 32;
    constexpr int NIT = 2 * I_GU + 2 * I_D + I_IN + I_B0 + I_B1 + I_B2 + I_O;
    const int r = F.lane & 31;
    const float* shl = F.mod + (size_t)l * BATCH * NADA;
    float* swl = F.SW + (size_t)l * 3 * BATCH * DIN;
    for (int it = gw; it < NIT; it += NGW) {
        int x = it;
        if (x < 2 * I_GU) { const int f = x / I_GU; x %= I_GU; const int kb = x / 176, nb = x % 176, p0 = nb * 32, t = p0 >> 8, bj = (p0 >> 7) & 1, wc = (p0 >> 5) & 3;
            const float* src = F.in[bj ? I_WU : I_WG] + (size_t)(l * 2 + f) * D * DFF;
            cv_item<true>(src, DFF, 128 * t + 32 * wc + perm32(r), (bf16*)(wb + (f ? WO_GU1 : WO_GU0)), D, p0, kb * 64, kb * 64, scr, F.lane, shl + (f ? 6 : 0) * D, swl + (f ? 2 : 0) * BATCH * DIN); continue; }
        x -= 2 * I_GU;
        if (x < I_IN) { const int kb = x / 176, nb = x % 176;
            cv_item<true>(F.in[I_WIN] + (size_t)l * D * DIN, DIN, nb * 32 + perm32(r), (bf16*)(wb + WO_IN), D, nb * 32, kb * 64, kb * 64, scr, F.lane, shl + 3 * D, swl + BATCH * DIN); continue; }
        x -= I_IN;
        if (x < 2 * I_D) { const int f = x / I_D; x %= I_D; const int kb = x / 32, nb = x % 32;
            cv_item<false>(F.in[I_WD] + (size_t)(l * 2 + f) * DFF * D, D, nb * 32 + r, (bf16*)(wb + (f ? WO_D1 : WO_D0)), DFF, nb * 32, kb * 64, kb * 64, scr, F.lane, nullptr, nullptr); continue; }
        x -= 2 * I_D;
        if (x < I_B0) { const int kb = x / 32, nb = x % 32;
            cv_item<false>(F.in[I_WBSB] + (size_t)l * 256 * D, D, nb * 32 + perm32(r), (bf16*)(wb + WO_BR), OC, nb * 32, kb * 64, kb * 64, scr, F.lane, nullptr, nullptr); continue; }
        x -= I_B0;
        if (x < I_B1) { const int kb = x / 32, nb = x % 32;
            cv_item<false>(F.in[I_WBDIL] + (size_t)l * 128 * D, D, nb * 32 + perm32(r), (bf16*)(wb + WO_BR), OC, nb * 32, kb * 64, 256 + kb * 64, scr, F.lane, nullptr, nullptr); continue; }
        x -= I_B1;
        if (x < I_B2) { const int kb = x / 32, nb = x % 32;
            cv_item<false>(F.in[I_WBSWA] + (size_t)l * 384 * D, D, nb * 32 + perm32(r), (bf16*)(wb + WO_BR), OC, nb * 32, kb * 64, 384 + kb * 64, scr, F.lane, nullptr, nullptr); continue; }
        x -= I_B2;
        { const int kb = x / 32, nb = x % 32;
            cv_item<false>(F.in[I_WOUT] + (size_t)l * D * D, D, nb * 32 + r, (bf16*)(wb + WO_OUT), D, nb * 32, kb * 64, kb * 64, scr, F.lane, nullptr, nullptr); }
    }
}

namespace pg8 {
typedef short bf16x8 __attribute__((ext_vector_type(8)));
constexpr int BM = 256, BK = 64, HALF = 128, HTB = HALF * BK * 2, STAGE_BYTES = 8 * HTB, NXCD = 8, WGM = 4;
__host__ __device__ __forceinline__ int lds_byte(int r, int c) { const int st = (r >> 4) * 2 + (c >> 5), rr = r & 15, cc = c & 31, ob = rr * 64 + cc * 2; return st * 1024 + (ob ^ (((ob >> 9) & 1) << 5)); }
__host__ __device__ __forceinline__ void stage_rc(int b, int& R, int& C) { const int st = b / 1024, sb = b % 1024, swz = sb ^ (((sb >> 9) & 1) << 5); R = (st >> 1) * 16 + swz / 64; C = (st & 1) * 32 + (swz % 64) / 2; }
struct Unit { int pm, pn, br, hf; };
struct Gemm { const bf16* A; const bf16* Bt; int ld; };
template <int NBR> struct StaticOrderT {
    int nM, nN, nwg, G, c; bool split;
    __device__ void init(int M_, int N_, int G_, int c_, bool split_ = false) { nM = M_ / BM; nN = N_ / BM; nwg = nM * nN; G = G_; c = c_; split = split_; }
    __device__ bool next(int i, Unit& u) const {
        const int ti = i / NBR, full = nwg / G, R = nwg - full * G;
        int wgid; u.hf = 0;
        if (ti < full) wgid = ti * G + c;
        else if (ti == full && R > 0) {
            if (split && 2 * R <= G) { const int t = 8 * (c >> 4) + (c & 7);
                if (t >= R) return false; wgid = full * G + t; u.hf = 1 + ((c >> 3) & 1); }
            else { if (c >= R) return false; wgid = full * G + c; } }
        else return false;
        { const int q = nwg / NXCD, r = nwg % NXCD, xcd = wgid % NXCD, off = wgid / NXCD; wgid = (xcd < r ? xcd * (q + 1) : r * (q + 1) + (xcd - r) * q) + off; }
        const int nig = WGM * nN, gid = wgid / nig, fm = gid * WGM, gsz = (nM - fm) < WGM ? (nM - fm) : WGM;
        u.pm = fm + ((wgid % nig) % gsz); u.pn = (wgid % nig) / gsz; u.br = i % NBR; return true;
    }
};
struct OrderK : StaticOrderT<1> {
    int ntiles;
    __device__ __forceinline__ int nt(const Unit&) const { return ntiles; }
    __device__ __forceinline__ int kofs(const Unit&) const { return 0; }
};
struct OrderBr : StaticOrderT<3> {
    __device__ __forceinline__ int nt(const Unit& u) const { return u.br == 0 ? 4 : (u.br == 1 ? 2 : 6); }
    __device__ __forceinline__ int kofs(const Unit& u) const { return u.br == 0 ? 0 : (u.br == 1 ? 256 : 384); }
};

template <class Epi, class Sched, bool ALIGN_EPI, bool SP2>
__device__ __forceinline__ void gemm_phase(LAS unsigned char* lds, const Gemm g, const Sched& S, const Epi& E) {
    const int tid = threadIdx.x, wid = __builtin_amdgcn_readfirstlane(tid >> 6), lane = tid & 63, wr = wid >> 2, wc = wid & 3, fr = lane & 15, fq = lane >> 4;
    const int LD = g.ld;
    unsigned voff[2];
#pragma unroll
    for (int i = 0; i < 2; ++i) { int R, C; stage_rc(tid * 16 + i * 8192, R, C); voff[i] = (unsigned)(R * LD + C) * 2u; }
    const size_t kstep = (size_t)(BK * 2);
    const size_t hstep = (size_t)HALF * LD * 2;
    const size_t tstep = 2 * hstep;
    const unsigned ldsw = (unsigned)wid * 1024u;
    const int aoff = lds_byte(wr * 64 + fr, fq * 8), boff = lds_byte(wc * 32 + fr, fq * 8);
#define PG8_SA(b, h) (((b) * 2 + (h)) * HTB)
#define PG8_SB(b, h) ((4 + (b) * 2 + (h)) * HTB)
#define PG8_STAGE(bufoff, gbase) do { _Pragma("unroll") for (int _i = 0; _i < 2; ++_i) \
        __builtin_amdgcn_global_load_lds((const unsigned*)((const char*)(gbase) + voff[_i]), (LAS unsigned*)(lds + (bufoff) + ldsw + _i * 8192), 16, 0, 0); } while (0)
#define PG8_LDA(dst, b, h) do { _Pragma("unroll") for (int m = 0; m < 4; ++m) _Pragma("unroll") for (int k = 0; k < 2; ++k) dst[m][k] = *(const LAS bf16x8*)(lds + PG8_SA(b, h) + aoff + m * 2048 + k * 1024); } while (0)
#define PG8_LDB(dst, b, h) do { _Pragma("unroll") for (int n = 0; n < 2; ++n) _Pragma("unroll") for (int k = 0; k < 2; ++k) dst[n][k] = *(const LAS bf16x8*)(lds + PG8_SB(b, h) + boff + n * 2048 + k * 1024); } while (0)
#define PG8_MMA(ai, bj, At, Bt) do { __builtin_amdgcn_s_setprio(1); _Pragma("unroll") for (int m = 0; m < 4; ++m) _Pragma("unroll") for (int n = 0; n < 2; ++n) _Pragma("unroll") for (int k = 0; k < 2; ++k) \
        acc[ai][bj][m][n] = __builtin_amdgcn_mfma_f32_16x16x32_bf16(Bt[n][k], At[m][k], acc[ai][bj][m][n], 0, 0, 0); __builtin_amdgcn_s_setprio(0); } while (0)
#define PG8_WAIT_V(n) asm volatile("s_waitcnt vmcnt(" #n ")" ::: "memory")
#define PG8_WAIT_L(n) asm volatile("s_waitcnt lgkmcnt(" #n ")" ::: "memory")
#define PG8_BAR __builtin_amdgcn_s_barrier()
#define PG8_SCHED __builtin_amdgcn_sched_barrier(0)
#define PG8_ZERO() do { _Pragma("unroll") for (int a_ = 0; a_ < 2; ++a_) _Pragma("unroll") for (int b_ = 0; b_ < 2; ++b_) _Pragma("unroll") for (int m_ = 0; m_ < 4; ++m_) _Pragma("unroll") for (int n_ = 0; n_ < 2; ++n_) acc[a_][b_][m_][n_] = (f32x4){0.f, 0.f, 0.f, 0.f}; } while (0)
    Unit cur, nxt; int ui = 0;
    if (!S.next(0, cur)) return;
    f32x4 acc[2][2][4][2];
    PG8_ZERO();
    bf16x8 At[4][2], B0[2][2], B1[2][2];
    const char* cA = (const char*)g.A + (size_t)cur.pm * tstep + (size_t)S.kofs(cur) * 2 + (cur.hf == 2 ? hstep : 0); const char* cB = (const char*)g.Bt + (size_t)cur.pn * tstep + (size_t)S.kofs(cur) * 2;
    if constexpr (SP2) {
        PG8_STAGE(PG8_SB(0, 0), cB); PG8_STAGE(PG8_SB(0, 1), cB + hstep); PG8_STAGE(PG8_SA(0, 0), cA); PG8_STAGE(PG8_SA(0, 1), cA + hstep);
        if (wr == 1) PG8_BAR;
        PG8_WAIT_V(2); PG8_BAR;
        PG8_STAGE(PG8_SB(1, 0), cB + kstep); PG8_STAGE(PG8_SA(1, 0), cA + kstep); PG8_STAGE(PG8_SB(1, 1), cB + hstep + kstep);
        PG8_WAIT_V(6); PG8_BAR;
    } else {
        PG8_STAGE(PG8_SB(0, 0), cB); PG8_STAGE(PG8_SA(0, 0), cA); PG8_STAGE(PG8_SB(0, 1), cB + hstep); PG8_STAGE(PG8_SA(0, 1), cA + hstep);
        if (wr == 1) PG8_BAR;
        PG8_WAIT_V(4); PG8_BAR;
        PG8_STAGE(PG8_SB(1, 0), cB + kstep); PG8_STAGE(PG8_SA(1, 0), cA + kstep); PG8_STAGE(PG8_SB(1, 1), cB + hstep + kstep);
        PG8_WAIT_V(6); PG8_BAR;
    }
    for (;;) {
        const bool has_next = S.next(ui + 1, nxt);
        const char* nA = has_next ? (const char*)g.A + (size_t)nxt.pm * tstep + (size_t)S.kofs(nxt) * 2 + (nxt.hf == 2 ? hstep : 0) : cA; const char* nB = has_next ? (const char*)g.Bt + (size_t)nxt.pn * tstep + (size_t)S.kofs(nxt) * 2 : cB;
        const int nt = S.nt(cur); const bool whole = cur.hf == 0;
        for (int t = 0; t < nt; t += 2) {
            const bool last = (t == nt - 2);
            const char* a1 = cA + (size_t)(t + 1) * kstep;
            const char* a2 = last ? nA : cA + (size_t)(t + 2) * kstep; const char* b2 = last ? nB : cB + (size_t)(t + 2) * kstep;
            const char* a3 = a2 + kstep; const char* b3 = b2 + kstep;
            if constexpr (SP2) {
            PG8_LDB(B0, 0, 0); PG8_LDB(B1, 0, 1); PG8_SCHED; PG8_LDA(At, 0, 0); PG8_STAGE(PG8_SA(1, 1), a1 + hstep);
            PG8_WAIT_V(8); PG8_WAIT_L(0); PG8_BAR; PG8_MMA(0, 0, At, B0); PG8_MMA(0, 1, At, B1); PG8_BAR; PG8_SCHED;
            if (whole) PG8_LDA(At, 0, 1); PG8_STAGE(PG8_SB(0, 0), b2); PG8_STAGE(PG8_SB(0, 1), b2 + hstep); PG8_STAGE(PG8_SA(0, 0), a2);
            PG8_WAIT_V(8); PG8_WAIT_L(0); PG8_BAR; if (whole) { PG8_MMA(1, 0, At, B0); PG8_MMA(1, 1, At, B1); } PG8_BAR; PG8_SCHED;
            PG8_LDB(B0, 1, 0); PG8_LDB(B1, 1, 1); PG8_SCHED; PG8_LDA(At, 1, 0); PG8_STAGE(PG8_SA(0, 1), a2 + hstep);
            PG8_WAIT_V(8); PG8_WAIT_L(0); PG8_BAR; PG8_MMA(0, 0, At, B0); PG8_MMA(0, 1, At, B1); PG8_BAR; PG8_SCHED;
            if (whole) PG8_LDA(At, 1, 1); PG8_STAGE(PG8_SB(1, 0), b3); PG8_STAGE(PG8_SB(1, 1), b3 + hstep); PG8_STAGE(PG8_SA(1, 0), a3);
            PG8_WAIT_V(8); PG8_WAIT_L(0); PG8_BAR; if (whole) { PG8_MMA(1, 0, At, B0); PG8_MMA(1, 1, At, B1); } PG8_BAR; PG8_SCHED;
            } else {
            PG8_LDB(B0, 0, 0); PG8_SCHED; PG8_LDA(At, 0, 0); PG8_STAGE(PG8_SA(1, 1), a1 + hstep);
            PG8_WAIT_L(8); PG8_BAR; PG8_WAIT_L(0); PG8_MMA(0, 0, At, B0); PG8_BAR; PG8_SCHED;
            PG8_LDB(B1, 0, 1); PG8_STAGE(PG8_SB(0, 0), b2);
            PG8_BAR; PG8_WAIT_L(0); PG8_MMA(0, 1, At, B1); PG8_BAR;
            PG8_LDA(At, 0, 1); PG8_STAGE(PG8_SA(0, 0), a2);
            PG8_BAR; PG8_WAIT_L(0); PG8_MMA(1, 0, At, B0); PG8_BAR; PG8_SCHED;
            PG8_STAGE(PG8_SB(0, 1), b2 + hstep);
            PG8_WAIT_V(6); PG8_BAR; PG8_MMA(1, 1, At, B1); PG8_BAR;
            PG8_LDB(B0, 1, 0); PG8_SCHED; PG8_LDA(At, 1, 0); PG8_STAGE(PG8_SA(0, 1), a2 + hstep);
            PG8_WAIT_L(8); PG8_BAR; PG8_WAIT_L(0); PG8_MMA(0, 0, At, B0); PG8_BAR; PG8_SCHED;
            PG8_LDB(B1, 1, 1); PG8_STAGE(PG8_SB(1, 0), b3);
            PG8_BAR; PG8_WAIT_L(0); PG8_MMA(0, 1, At, B1); PG8_BAR;
            PG8_LDA(At, 1, 1); PG8_STAGE(PG8_SA(1, 0), a3);
            PG8_BAR; PG8_WAIT_L(0); PG8_MMA(1, 0, At, B0); PG8_BAR; PG8_SCHED;
            PG8_STAGE(PG8_SB(1, 1), b3 + hstep);
            PG8_WAIT_V(6); PG8_BAR; PG8_MMA(1, 1, At, B1); PG8_BAR;
            }
        }
        if constexpr (ALIGN_EPI) { if (wr == 0) PG8_BAR; }
        const bool keep = E(acc, cur, wr, wc, fr, fq);
        if (!has_next) break;
        if (!keep) PG8_ZERO();
        cur = nxt; cA = nA; cB = nB; ++ui;
        if constexpr (ALIGN_EPI) { if (wr == 1) PG8_BAR; }
    }
    PG8_WAIT_V(0);
    if constexpr (!ALIGN_EPI) { if (wr == 0) PG8_BAR; }
    PG8_BAR;
#undef PG8_SA
#undef PG8_SB
#undef PG8_STAGE
#undef PG8_LDA
#undef PG8_LDB
#undef PG8_MMA
#undef PG8_WAIT_V
#undef PG8_WAIT_L
#undef PG8_BAR
#undef PG8_SCHED
#undef PG8_ZERO
}

template <bool NEXT, bool HALFCS> struct EpiXupd {
    const float* xin; float* xout; const float* gate0;
    bf16* hout; const float* ng; const float* nscale0; float* ss;
    __device__ __forceinline__ bool operator()(f32x4 (&acc)[2][2][4][2], const Unit& u, int wr, int wc, int fr, int fq) const {
        const float* const xin = this->xin; float* const xout = this->xout; const float* const gate0 = this->gate0; constexpr float cs = HALFCS ? 0.5f : 1.0f;
        bf16* const hout = this->hout; const float* const ng = this->ng; const float* const nscale0 = this->nscale0; float* const ss = this->ss;
        const int row0 = u.pm * BM + wr * 64 + fr, col0 = u.pn * BM + wc * 32 + 4 * fq; const int b = u.pm >> 3;
        const float* gp = gate0 + (size_t)b * NADA + col0;
        { f32x4 cv[2][2];
#pragma unroll
          for (int bj = 0; bj < 2; ++bj)
#pragma unroll
              for (int n = 0; n < 2; ++n) cv[bj][n] = *(const f32x4*)(gp + bj * HALF + n * 16) * cs;
#pragma unroll
          for (int ai = 0; ai < 2; ++ai)
#pragma unroll
              for (int bj = 0; bj < 2; ++bj)
#pragma unroll
                  for (int m = 0; m < 4; ++m)
#pragma unroll
                      for (int n = 0; n < 2; ++n) acc[ai][bj][m][n] *= cv[bj][n]; }
        f32x4 gs[2][2];
        if (NEXT) { f32x4 t0[2][2], t1[2][2];
#pragma unroll
          for (int bj = 0; bj < 2; ++bj)
#pragma unroll
              for (int n = 0; n < 2; ++n) { t0[bj][n] = *(const f32x4*)(ng + col0 + bj * HALF + n * 16); t1[bj][n] = *(const f32x4*)(nscale0 + (size_t)b * NADA + col0 + bj * HALF + n * 16); }
#pragma unroll
          for (int bj = 0; bj < 2; ++bj)
#pragma unroll
              for (int n = 0; n < 2; ++n) gs[bj][n] = t0[bj][n] * (1.0f + t1[bj][n]); }
        f32x4 xv[3][2][2];
#define XU_LOAD(g) do { _Pragma("unroll") for (int bj = 0; bj < 2; ++bj) _Pragma("unroll") for (int n = 0; n < 2; ++n) \
            xv[(g) % 3][bj][n] = *(const f32x4*)(xin + (size_t)(row0 + ((g) >> 2) * HALF + ((g) & 3) * 16) * D + col0 + bj * HALF + n * 16); } while (0)
        XU_LOAD(0); XU_LOAD(1);
#pragma unroll
        for (int g = 0; g < 8; ++g) {
            if (g + 2 < 8) XU_LOAD(g + 2);
            asm volatile("" ::: "memory");
            const int ai = g >> 2, m = g & 3; const int row = row0 + ai * HALF + m * 16; const size_t off = (size_t)row * D + col0; float sq = 0.f;
#pragma unroll
            for (int bj = 0; bj < 2; ++bj)
#pragma unroll
                for (int n = 0; n < 2; ++n) { const f32x4 xn = xv[g % 3][bj][n] + acc[ai][bj][m][n];
                    *(f32x4*)(xout + off + bj * HALF + n * 16) = xn;
                    if (NEXT) { sq += (xn.x * xn.x + xn.y * xn.y) + (xn.z * xn.z + xn.w * xn.w); const f32x4 hv = xn * gs[bj][n];
                        u32x2 w; w.x = pk2(hv.x, hv.y); w.y = pk2(hv.z, hv.w); *(u32x2*)(hout + off + bj * HALF + n * 16) = w; } }
            if (NEXT) { sq += __shfl_xor(sq, 16); sq += __shfl_xor(sq, 32); if (fq == 0) atomicAdd(ss + row, sq); }
            asm volatile("" ::: "memory");
        }
#undef XU_LOAD
        return false;
    }
};
struct EpiSwiglu {
    bf16* act; const float* ss; const float* sw0;
    __device__ __forceinline__ bool operator()(f32x4 (&acc)[2][2][4][2], const Unit& u, int wr, int wc, int fr, int fq) const {
        const int row0 = u.pm * BM + (u.hf == 2 ? HALF : 0) + wr * 64 + fr, col0 = u.pn * HALF + wc * 32 + 8 * fq;
        const float* sp = sw0 + (size_t)(u.pm >> 3) * DIN + u.pn * BM + wc * 32 + 4 * fq;
        f32x4 sv[2][2]; float sq[2][4];
#pragma unroll
        for (int bj = 0; bj < 2; ++bj)
#pragma unroll
            for (int n = 0; n < 2; ++n) sv[bj][n] = *(const f32x4*)(sp + bj * HALF + n * 16);
#pragma unroll
        for (int ai = 0; ai < 2; ++ai)
#pragma unroll
            for (int m = 0; m < 4; ++m) sq[ai][m] = ss[row0 + ((ai == 1 && u.hf != 0) ? 0 : ai) * HALF + m * 16];
        asm volatile("" ::: "memory");
#pragma unroll
        for (int ai = 0; ai < 2; ++ai) { if (ai == 1 && u.hf != 0) break;
#pragma unroll
            for (int m = 0; m < 4; ++m) {
                const int row = row0 + ai * HALF + m * 16; const float rs = __builtin_amdgcn_rsqf(sq[ai][m] * (1.0f / D) + RMS_EPS);
                const f32x4 g0 = acc[ai][0][m][0] * rs + sv[0][0], g1 = acc[ai][0][m][1] * rs + sv[0][1], u0 = acc[ai][1][m][0] * rs + sv[1][0], u1 = acc[ai][1][m][1] * rs + sv[1][1];
                u32x4 w;
                w.x = pk2(silu_f(g0[0]) * u0[0], silu_f(g0[1]) * u0[1]); w.y = pk2(silu_f(g0[2]) * u0[2], silu_f(g0[3]) * u0[3]);
                w.z = pk2(silu_f(g1[0]) * u1[0], silu_f(g1[1]) * u1[1]); w.w = pk2(silu_f(g1[2]) * u1[2], silu_f(g1[3]) * u1[3]);
                *(u32x4*)(act + (size_t)row * DFF + col0) = w;
            } }
        return false;
    }
};
struct EpiQkvg {
    bf16* out; const float* ss; const float* sw0;
    __device__ __forceinline__ bool operator()(f32x4 (&acc)[2][2][4][2], const Unit& u, int wr, int wc, int fr, int fq) const {
        const int row0 = u.pm * BM + (u.hf == 2 ? HALF : 0) + wr * 64 + fr; const int nai = u.hf != 0 ? 1 : 2;
        const float* sp = sw0 + (size_t)(u.pm >> 3) * DIN + u.pn * BM + wc * 32 + 4 * fq;
        float rs[2][4]; f32x4 sv[2][2];
#pragma unroll
        for (int bj = 0; bj < 2; ++bj) { sv[bj][0] = *(const f32x4*)(sp + bj * HALF); sv[bj][1] = *(const f32x4*)(sp + bj * HALF + 16); }
#pragma unroll
        for (int ai = 0; ai < 2; ++ai)
#pragma unroll
            for (int m = 0; m < 4; ++m) rs[ai][m] = ss[row0 + (ai < nai ? ai : 0) * HALF + m * 16];
        asm volatile("" ::: "memory");
#pragma unroll
        for (int ai = 0; ai < 2; ++ai)
#pragma unroll
            for (int m = 0; m < 4; ++m) rs[ai][m] = __builtin_amdgcn_rsqf(rs[ai][m] * (1.0f / D) + RMS_EPS);
#pragma unroll
        for (int bj = 0; bj < 2; ++bj) {
            const int c = u.pn * BM + bj * HALF;
            const bool isq = (c < C_KSB) || (c >= C_QDIL && c < C_KDIL) || (c >= C_QSWA && c < C_KSWA), isg = c >= C_GATE;
            const int col0 = c + wc * 32 + 8 * fq;
            const f32x4 s0 = sv[bj][0], s1 = sv[bj][1];
#pragma unroll
            for (int ai = 0; ai < 2; ++ai) { if (ai >= nai) break;
#pragma unroll
                for (int m = 0; m < 4; ++m) {
                    f32x4 v0 = acc[ai][bj][m][0] * rs[ai][m] + s0, v1 = acc[ai][bj][m][1] * rs[ai][m] + s1;
                    if (isq) { v0 = v0 * QSCALE; v1 = v1 * QSCALE; }
                    if (isg) {
#pragma unroll
                        for (int e = 0; e < 4; ++e) { v0[e] = sigm_f(v0[e]); v1[e] = sigm_f(v1[e]); } }
                    u32x4 w; w.x = pk2(v0[0], v0[1]); w.y = pk2(v0[2], v0[3]); w.z = pk2(v1[0], v1[1]); w.w = pk2(v1[2], v1[3]);
                    *(u32x4*)(out + (size_t)(row0 + ai * HALF + m * 16) * DIN + col0) = w;
                } }
        }
        return false;
    }
};
struct EpiBranch {
    const bf16* gates;
    bf16* out;
    __device__ __forceinline__ bool operator()(f32x4 (&acc)[2][2][4][2], const Unit& u, int wr, int wc, int fr, int fq) const {
        const int row0 = u.pm * BM + wr * 64 + fr; const int br = u.br;
#pragma unroll
        for (int ai = 0; ai < 2; ++ai) {
            u32x4 sc[4][2], sn[4][2];
#pragma unroll
            for (int m = 0; m < 4; ++m)
#pragma unroll
                for (int bj = 0; bj < 2; ++bj) { const size_t go = (size_t)(row0 + ai * HALF + m * 16) * DIN + u.pn * BM + bj * HALF + wc * 32 + 8 * fq;
                    sc[m][bj] = *(const u32x4*)(gates + go + br * D); if (br < 2) sn[m][bj] = *(const u32x4*)(gates + go + (br + 1) * D); else sn[m][bj] = sc[m][bj]; }
            asm volatile("" ::: "memory");
#pragma unroll
            for (int m = 0; m < 4; ++m)
#pragma unroll
                for (int bj = 0; bj < 2; ++bj) {
                    const int row = row0 + ai * HALF + m * 16, col0 = u.pn * BM + bj * HALF + wc * 32 + 8 * fq;
                    const u32x4 c4 = sc[m][bj], n4 = sn[m][bj];
                    float f[8] = {bf2f(c4.x & 0xffffu), bf2f(c4.x >> 16), bf2f(c4.y & 0xffffu), bf2f(c4.y >> 16), bf2f(c4.z & 0xffffu), bf2f(c4.z >> 16), bf2f(c4.w & 0xffffu), bf2f(c4.w >> 16)};
                    if (br < 2) {
                        const float d[8] = {bf2f(n4.x & 0xffffu), bf2f(n4.x >> 16), bf2f(n4.y & 0xffffu), bf2f(n4.y >> 16), bf2f(n4.z & 0xffffu), bf2f(n4.z >> 16), bf2f(n4.w & 0xffffu), bf2f(n4.w >> 16)};
#pragma unroll
                        for (int e = 0; e < 8; ++e) f[e] = f[e] * __builtin_amdgcn_rcpf(fmaxf(d[e], 1e-30f));
                    }
                    f32x4 v0 = acc[ai][bj][m][0], v1 = acc[ai][bj][m][1];
                    v0[0] *= f[0]; v0[1] *= f[1]; v0[2] *= f[2]; v0[3] *= f[3]; v1[0] *= f[4]; v1[1] *= f[5]; v1[2] *= f[6]; v1[3] *= f[7];
                    if (br < 2) { acc[ai][bj][m][0] = v0; acc[ai][bj][m][1] = v1; }
                    else { u32x4 w; w.x = pk2(v0[0], v0[1]); w.y = pk2(v0[2], v0[3]); w.z = pk2(v1[0], v1[1]); w.w = pk2(v1[2], v1[3]); *(u32x4*)(out + (size_t)row * D + col0) = w; }
                }
            asm volatile("" ::: "memory");
        }
        return br < 2;
    }
};
}

template <bool NEXT, bool HALFCS>
__device__ __forceinline__ void ph_xupd(Frame& F, const bf16* A, int K, const bf16* Bt, const float* xin, float* xout, bf16* hout, int l, int j, int nl, int nj) {
    pg8::Gemm g{A, Bt, K}; pg8::OrderK S; S.init(M, D, F.G, F.wg); S.ntiles = K / 64;
    const float* gate0 = F.mod + (size_t)l * BATCH * NADA + (j * 3 + 2) * D;
    pg8::EpiXupd<NEXT, HALFCS> E{xin, xout, gate0, NEXT ? hout : nullptr, NEXT ? F.in[I_NG] + (nl * 3 + nj) * D : nullptr, NEXT ? F.mod + (size_t)nl * BATCH * NADA + (nj * 3 + 1) * D : nullptr, NEXT ? F.SS + (size_t)(nl * 3 + nj) * M : nullptr};
    pg8::gemm_phase<pg8::EpiXupd<NEXT, HALFCS>, pg8::OrderK, false, true>(F.lds, g, S, E);
}
__device__ __forceinline__ void ph_ffn_up(Frame& F, const bf16* A, const bf16* Bt, int l, int j) {
    pg8::Gemm g{A, Bt, D}; pg8::OrderK S; S.init(M, 2 * DFF, F.G, F.wg, true); S.ntiles = D / 64;
    pg8::EpiSwiglu E{F.ACT, F.SS + (size_t)(l * 3 + j) * M, F.SW + (size_t)(l * 3 + j) * BATCH * DIN};
    pg8::gemm_phase<pg8::EpiSwiglu, pg8::OrderK, true, true>(F.lds, g, S, E);
}
__device__ __forceinline__ void ph_inproj(Frame& F, int l) {
    pg8::Gemm g{F.H, (const bf16*)(F.ws + WS_W + WO_IN), D}; pg8::OrderK S; S.init(M, DIN, F.G, F.wg, true); S.ntiles = D / 64;
    pg8::EpiQkvg E{F.QKVG, F.SS + (size_t)(l * 3 + 1) * M, F.SW + (size_t)(l * 3 + 1) * BATCH * DIN};
    pg8::gemm_phase<pg8::EpiQkvg, pg8::OrderK, true, true>(F.lds, g, S, E);
}
__device__ __forceinline__ void ph_branch(Frame& F) {
    pg8::Gemm g{F.OCAT, (const bf16*)(F.ws + WS_W + WO_BR), OC}; pg8::OrderBr S; S.init(M, D, F.G, F.wg);
    pg8::EpiBranch E{F.QKVG + C_GATE, F.H};
    pg8::gemm_phase<pg8::EpiBranch, pg8::OrderBr, true, true>(F.lds, g, S, E);
}

namespace att {
typedef float f32x16 __attribute__((ext_vector_type(16)));
typedef short bf16x8 __attribute__((ext_vector_type(8)));
typedef short s16x4 __attribute__((ext_vector_type(4)));
typedef short v4i16_t __attribute__((ext_vector_type(4)));
constexpr int KP = 144, LW_K = 0, LW_V = 4608, LW_F = 8704, LW_BYTES = 9216, LDS_BTAB = 8 * LW_BYTES, BT_PITCH = 132;
#define ATT_FENCE() asm volatile("" ::: "memory")
__device__ __forceinline__ int crow(int r, int h) { return (r & 3) + 8 * (r >> 2) + 4 * h; }
__device__ __forceinline__ s16x4 vtr(const LAS unsigned char* p) { return __builtin_bit_cast(s16x4, __builtin_amdgcn_ds_read_tr16_b64_v4i16((LAS v4i16_t*)p)); }
__device__ __forceinline__ float swap_other(float x, int hh) { auto rr = __builtin_amdgcn_permlane32_swap(__float_as_uint(x), __float_as_uint(x), false, false); return __uint_as_float(hh ? rr[0] : rr[1]); }

struct KVRegs { u32x4 k[4], v[4]; };
__device__ __forceinline__ void kv_issue(KVRegs& R, const bf16* base, int kcol, int vcol, const int (&tok)[4], int lane) {
#pragma unroll
    for (int i = 0; i < 4; ++i) { const bf16* pr = base + (size_t)tok[i] * DIN + (lane & 7) * 8; R.k[i] = *(const u32x4*)(pr + kcol); R.v[i] = *(const u32x4*)(pr + vcol); }
}
__device__ __forceinline__ void kv_write(LAS unsigned char* wl, const KVRegs& R, int lane) {
    const int row = lane >> 3, ch = lane & 7;
    ATT_FENCE();
#pragma unroll
    for (int i = 0; i < 4; ++i) { *(LAS u32x4*)(wl + LW_K + (row + 8 * i) * KP + ch * 16) = R.k[i]; *(LAS u32x4*)(wl + LW_V + (ch >> 2) * 2048 + (row + 8 * i) * 64 + (ch & 3) * 16) = R.v[i]; }
    ATT_FENCE();
}
__device__ __forceinline__ f32x16 qk_tile(const LAS unsigned char* wl, const bf16x8 (&qf)[4], int lane) {
    const LAS unsigned char* kp = wl + LW_K + (lane & 31) * KP + (lane >> 5) * 16;
    f32x16 S = {};
#pragma unroll
    for (int d0 = 0; d0 < 4; ++d0) { const bf16x8 kf = *(const LAS bf16x8*)(kp + d0 * 32); S = __builtin_amdgcn_mfma_f32_32x32x16_bf16(kf, qf[d0], S, 0, 0, 0); }
    return S;
}
__device__ __forceinline__ void pv_tile(const LAS unsigned char* wl, const float (&w)[16], f32x16& o0, f32x16& o1, int lane) {
    const int hh = lane >> 5;
    const LAS unsigned char* vp = wl + LW_V + ((lane >> 4) & 1) * 32 + (lane & 3) * 8 + (4 * hh + ((lane & 15) >> 2)) * 64;
    s16x4 lo[2][2], hi[2][2];
#pragma unroll
    for (int s2 = 0; s2 < 2; ++s2)
#pragma unroll
        for (int dh = 0; dh < 2; ++dh) { lo[s2][dh] = vtr(vp + dh * 2048 + s2 * 1024); hi[s2][dh] = vtr(vp + dh * 2048 + s2 * 1024 + 512); }
#pragma unroll
    for (int s2 = 0; s2 < 2; ++s2) {
        u32x4 pw; pw.x = pk2(w[8 * s2 + 0], w[8 * s2 + 1]); pw.y = pk2(w[8 * s2 + 2], w[8 * s2 + 3]); pw.z = pk2(w[8 * s2 + 4], w[8 * s2 + 5]); pw.w = pk2(w[8 * s2 + 6], w[8 * s2 + 7]);
        const bf16x8 pa = __builtin_bit_cast(bf16x8, pw);
        const bf16x8 v0 = {lo[s2][0][0], lo[s2][0][1], lo[s2][0][2], lo[s2][0][3], hi[s2][0][0], hi[s2][0][1], hi[s2][0][2], hi[s2][0][3]};
        const bf16x8 v1 = {lo[s2][1][0], lo[s2][1][1], lo[s2][1][2], lo[s2][1][3], hi[s2][1][0], hi[s2][1][1], hi[s2][1][2], hi[s2][1][3]};
        o0 = __builtin_amdgcn_mfma_f32_32x32x16_bf16(pa, v0, o0, 0, 0, 0);
        o1 = __builtin_amdgcn_mfma_f32_32x32x16_bf16(pa, v1, o1, 0, 0, 0);
    }
}
__device__ __forceinline__ void store_o(LAS unsigned char* wl, const f32x16& o0, const f32x16& o1, float qscale, bf16* dst, const int (&qtok)[4], int lane) {
    const int r = lane & 31, hh = lane >> 5;
    LAS float* fs = (LAS float*)(wl + LW_F); LAS unsigned short* stg = (LAS unsigned short*)(wl + LW_K);
    ATT_FENCE();
    if (hh == 0) fs[r] = qscale;
    ATT_FENCE();
#pragma unroll
    for (int gi = 0; gi < 4; ++gi) { const f32x4 sc = *(const LAS f32x4*)(fs + 8 * gi + 4 * hh);
#pragma unroll
        for (int e = 0; e < 4; ++e) { const int q = 8 * gi + 4 * hh + e; stg[q * 64 + r] = (unsigned short)f2bf(o0[4 * gi + e] * sc[e]); stg[q * 64 + 32 + r] = (unsigned short)f2bf(o1[4 * gi + e] * sc[e]); } }
    ATT_FENCE();
#pragma unroll
    for (int i = 0; i < 4; ++i) { const int row = (lane >> 3) + 8 * i; const u32x4 v = *(const LAS u32x4*)(stg + row * 64 + (lane & 7) * 8); *(u32x4*)(dst + (size_t)qtok[i] * OC + (lane & 7) * 8) = v; }
    ATT_FENCE();
}

__device__ __forceinline__ void sb_item(const bf16* qkvg, bf16* ocat, int b, int h, int qt, LAS unsigned char* wl, int lane) {
    const int r = lane & 31, hh = lane >> 5; const bf16* base = qkvg + (size_t)b * SEQ * DIN;
    bf16x8 qf[4];
#pragma unroll
    for (int d0 = 0; d0 < 4; ++d0) qf[d0] = *(const bf16x8*)(base + (size_t)(qt * 32 + r) * DIN + C_QSB + h * HD + 16 * d0 + 8 * hh);
    f32x16 o0 = {}, o1 = {}; float carry = 1.0f;
    KVRegs R0, R1;
#define SB_ISSUE(R_, kt_) do { int tok[4]; _Pragma("unroll") for (int i = 0; i < 4; ++i) tok[i] = (kt_) * 32 + (lane >> 3) + 8 * i; kv_issue(R_, base, C_KSB + h * HD, C_VSB + h * HD, tok, lane); } while (0)
    SB_ISSUE(R0, qt); if (qt > 0) SB_ISSUE(R1, qt - 1);
    asm volatile("" :: "v"(qf[0]), "v"(qf[1]), "v"(qf[2]), "v"(qf[3]));
    auto tile = [&](int kt) -> bool {
        const f32x16 S = qk_tile(wl, qf, lane);
        float f[16], be[16];
#pragma unroll
        for (int g = 0; g < 16; ++g) { const float e = __builtin_amdgcn_exp2f(fminf(S[g], 80.f)); const float fr = __builtin_amdgcn_rcpf(1.0f + e); f[g] = fr; be[g] = e * fr; }
        if (kt == qt) {
#pragma unroll
            for (int g = 0; g < 16; ++g) { const bool valid = crow(g, hh) < r; f[g] = valid ? f[g] : 1.0f; be[g] = valid ? be[g] : 0.0f; }
        }
        float X[16], T0[4], T1[4];
#pragma unroll
        for (int gi = 0; gi < 4; ++gi) { const float L3 = f[4 * gi + 3], L2 = f[4 * gi + 2] * L3, L1 = f[4 * gi + 1] * L2, L0 = f[4 * gi] * L1;
            X[4 * gi + 3] = 1.0f; X[4 * gi + 2] = L3; X[4 * gi + 1] = L2; X[4 * gi] = L1;
            auto rr = __builtin_amdgcn_permlane32_swap(__float_as_uint(L0), __float_as_uint(L0), false, false); T0[gi] = __uint_as_float(rr[0]); T1[gi] = __uint_as_float(rr[1]); }
        float E[4]; E[3] = carry; E[2] = E[3] * (T0[3] * T1[3]); E[1] = E[2] * (T0[2] * T1[2]); E[0] = E[1] * (T0[1] * T1[1]); carry = E[0] * (T0[0] * T1[0]);
        float w[16];
#pragma unroll
        for (int g = 0; g < 16; ++g) { const float eg = hh ? E[g >> 2] : E[g >> 2] * T1[g >> 2]; w[g] = be[g] * (eg * X[g]); }
        pv_tile(wl, w, o0, o1, lane);
        return __all(carry < 1.2e-38f) != 0;
    };
    for (int kt = qt; kt >= 0; kt -= 2) {
        kv_write(wl, R0, lane); if (kt > 1) SB_ISSUE(R0, kt - 2);
        if (tile(kt)) break;
        if (kt == 0) break;
        kv_write(wl, R1, lane); if (kt > 2) SB_ISSUE(R1, kt - 3);
        if (tile(kt - 1)) break;
    }
#undef SB_ISSUE
    int qtok[4];
#pragma unroll
    for (int i = 0; i < 4; ++i) qtok[i] = qt * 32 + (lane >> 3) + 8 * i;
    store_o(wl, o0, o1, 1.0f, ocat + (size_t)b * SEQ * OC + h * HD, qtok, lane);
}

struct BandState { float m, l; f32x16 o0, o1; };
__device__ __forceinline__ void band_group(BandState& st, const bf16* base, int qtok, int qcol, int kcol, int vcol, int d, int sstep, int P0, int kres, int NT, int maxd,
                                           const LAS float* bt, LAS unsigned char* wl, int lane) {
    const int r = lane & 31, hh = lane >> 5;
    LAS float* fs = (LAS float*)(wl + LW_F);
    bf16x8 qf[4];
#pragma unroll
    for (int d0 = 0; d0 < 4; ++d0) qf[d0] = *(const bf16x8*)(base + (size_t)qtok * DIN + qcol + 16 * d0 + 8 * hh);
    const int c0 = P0 >= 128 ? 0 : ((128 - P0) >> 5);
    KVRegs R0, R1;
#define BAND_ISSUE(R_, cc) do { int tok[4]; const int ib_ = P0 - 128 + 32 * (cc); _Pragma("unroll") for (int i = 0; i < 4; ++i) { const int ix = ib_ + (lane >> 3) + 8 * i; const int tk = kres + d * (ix < 0 ? 0 : ix); tok[i] = tk > SEQ - 1 ? SEQ - 1 : tk; } \
        kv_issue(R_, base, kcol, vcol, tok, lane); } while (0)
    BAND_ISSUE(R0, c0); if (c0 + 1 < NT) BAND_ISSUE(R1, c0 + 1);
    asm volatile("" :: "v"(qf[0]), "v"(qf[1]), "v"(qf[2]), "v"(qf[3]));
    auto tile = [&](int c) {
        const int idx0 = P0 - 128 + 32 * c;
        const f32x16 S = qk_tile(wl, qf, lane);
        float sc[16]; float mx = -1e30f;
        const int rel0 = sstep * r + 128 - 32 * c - 4 * hh;
#pragma unroll
        for (int g = 0; g < 16; ++g) { const int rel = rel0 - (g & 3) - 8 * (g >> 2); const int ri = (rel < -1 ? -1 : (rel > maxd + 1 ? maxd + 1 : rel)) + 1; sc[g] = S[g] + bt[ri]; }
        if (idx0 < 0) {
#pragma unroll
            for (int g = 0; g < 16; ++g) sc[g] = (idx0 + crow(g, hh) >= 0) ? sc[g] : -1e30f;
        }
#pragma unroll
        for (int g = 0; g < 16; ++g) mx = fmaxf(mx, sc[g]);
        mx = fmaxf(mx, swap_other(mx, hh));
        if (__any(mx > st.m + 8.0f)) {
            const float mn = fmaxf(st.m, mx), fsc = __builtin_amdgcn_exp2f(st.m - mn); st.l *= fsc; st.m = mn;
            ATT_FENCE(); if (hh == 0) fs[r] = fsc; ATT_FENCE();
#pragma unroll
            for (int gi = 0; gi < 4; ++gi) { const f32x4 fv = *(const LAS f32x4*)(fs + 8 * gi + 4 * hh);
#pragma unroll
                for (int e = 0; e < 4; ++e) { st.o0[4 * gi + e] *= fv[e]; st.o1[4 * gi + e] *= fv[e]; } }
            ATT_FENCE();
        }
        float w[16]; float ls = 0.f;
#pragma unroll
        for (int g = 0; g < 16; ++g) { w[g] = __builtin_amdgcn_exp2f(sc[g] - st.m); ls += w[g]; }
        st.l += ls;
        pv_tile(wl, w, st.o0, st.o1, lane);
    };
    for (int c = c0; c < NT; c += 2) {
        kv_write(wl, R0, lane); if (c + 2 < NT) BAND_ISSUE(R0, c + 2);
        tile(c);
        if (c + 1 >= NT) break;
        kv_write(wl, R1, lane); if (c + 3 < NT) BAND_ISSUE(R1, c + 3);
        tile(c + 1);
    }
#undef BAND_ISSUE
}
}

__device__ __forceinline__ void ph_attn(Frame& F, int l) {
    using namespace att;
    LAS float* btab = (LAS float*)(F.lds + LDS_BTAB);
    const float* relb = F.in[I_RELB];
    for (int idx = F.tid; idx < 12 * 131; idx += NTHREADS) { const int head = idx / 131, e = idx % 131; const int dd = head < 2 ? 1 : (head < 4 ? 4 : (head < 6 ? 16 : 1)), maxd = head < 6 ? 128 : 127;
        const int rel = e - 1;
        btab[head * BT_PITCH + e] = (rel < 0 || rel > maxd) ? -1e30f : relb[t5_bucket(rel * dd) * 12 + head] * LOG2E; }
    __syncthreads();
    LAS unsigned char* wl = F.lds + F.wave * LW_BYTES;
    const int lane = F.lane, r = lane & 31, hh = lane >> 5;
    const int half = F.wave >> 1, NH = F.G * (NTHREADS / 128); const int j0 = F.wg * (NTHREADS / 128) + half;
    if ((F.wave & 1) == 0) {
        for (int it = j0; it < 1024; it += NH) {
            const int b = it >> 7, slot = (it >> 6) & 1, r16 = (it >> 2) & 15, i0 = (it & 3) * 32;
            const bf16* base = F.QKVG + (size_t)b * SEQ * DIN; const int qtok = r16 + 16 * (i0 + r);
            BandState st; st.m = -1e20f; st.l = 0.f; st.o0 = f32x16{}; st.o1 = f32x16{};
            band_group(st, base, qtok, C_QDIL + (4 + slot) * HD, C_KDIL + (4 + slot) * HD, C_VDIL + (4 + slot) * HD, 16, 1, i0, r16, 5, 128, btab + (4 + slot) * BT_PITCH, wl, lane);
            band_group(st, base, qtok, C_QDIL + (2 + slot) * HD, C_KDIL + (2 + slot) * HD, C_VDIL + (2 + slot) * HD, 4, 4, (r16 >> 2) + 4 * i0, r16 & 3, 8, 128, btab + (2 + slot) * BT_PITCH, wl, lane);
            band_group(st, base, qtok, C_QDIL + slot * HD, C_KDIL + slot * HD, C_VDIL + slot * HD, 1, 16, r16 + 16 * i0, 0, 20, 128, btab + slot * BT_PITCH, wl, lane);
            const float lt = st.l + swap_other(st.l, hh);
            int qt4[4];
#pragma unroll
            for (int i = 0; i < 4; ++i) qt4[i] = r16 + 16 * (i0 + (lane >> 3) + 8 * i);
            store_o(wl, st.o0, st.o1, 1.0f / lt, F.OCAT + (size_t)b * SEQ * OC + 256 + slot * HD, qt4, lane);
        }
    } else {
        for (int x = j0; x < 2048; x += NH) {
            const int qt = 63 - (x >> 5), b = (x & 31) >> 2, h = x & 3;
            sb_item(F.QKVG, F.OCAT, b, h, qt, wl, lane);
        }
        for (int x = j0; x < 3072; x += NH) {
            const int hq = x % 6, qt = (x / 6) % 64, b = x / 384, kv = hq / 3;
            const bf16* base = F.QKVG + (size_t)b * SEQ * DIN;
            const float sk = F.in[I_SINKS][l * 6 + hq] * LOG2E;
            BandState st; st.m = sk; st.l = 0.f; st.o0 = f32x16{}; st.o1 = f32x16{};
            band_group(st, base, qt * 32 + r, C_QSWA + hq * HD, C_KSWA + kv * HD, C_VSWA + kv * HD, 1, 1, qt * 32, 0, 5, 127, btab + (6 + hq) * BT_PITCH, wl, lane);
            const float lt = st.l + swap_other(st.l, hh) + __builtin_amdgcn_exp2f(sk - st.m);
            int qt4[4];
#pragma unroll
            for (int i = 0; i < 4; ++i) qt4[i] = qt * 32 + (lane >> 3) + 8 * i;
            store_o(wl, st.o0, st.o1, 1.0f / lt, F.OCAT + (size_t)b * SEQ * OC + 384 + hq * HD, qt4, lane);
        }
    }
}

#define XB_TMO      128
#define XB_XCNT(j)  (256  + 64 * (j))
#define XB_XSUB(j)  (1280 + 64 * (j))
#define XB_XGEN(j)  (2304 + 64 * (j))
#define XB_TOP      3328
#define XB_TOPGEN   3392
#define XCD_BAR_WORDS 3456
#define XB_SPIN_CAP (1u << 18)
__device__ __forceinline__ unsigned xb_ld(unsigned* p)              { return __hip_atomic_load(p, __ATOMIC_RELAXED, __HIP_MEMORY_SCOPE_AGENT); }
__device__ __forceinline__ unsigned xb_add(unsigned* p, unsigned v) { return __hip_atomic_fetch_add(p, v, __ATOMIC_RELAXED, __HIP_MEMORY_SCOPE_AGENT); }
__device__ __forceinline__ unsigned xb_xcc_id() { return (unsigned)__builtin_amdgcn_s_getreg((3 << 11) | 20) & 0xFu; }
#define XB_SPIN(cond, bar) do { unsigned _sp = 0; while (cond) { __builtin_amdgcn_s_sleep(1); \
    if ((++_sp & 255u) == 0u) { if (xb_ld(&(bar)[XB_TMO])) break; if (_sp > XB_SPIN_CAP) { atomicAdd(&(bar)[XB_TMO], 1u); break; } } } } while (0)
struct XcdBarrier { unsigned* bar; unsigned x; volatile LAS unsigned* st; };
__device__ __forceinline__ XcdBarrier xcd_barrier_post(unsigned* bar, volatile LAS unsigned* st) {
    XcdBarrier b; b.bar = bar; b.x = xb_xcc_id(); b.st = st;
    if (threadIdx.x == 0) (void)xb_add(&bar[XB_XCNT(b.x)], 1u);
    return b;
}
__device__ __forceinline__ void xcd_barrier_complete(unsigned* bar, unsigned x, unsigned& nloc, unsigned& nx) {
    const unsigned G = gridDim.x * gridDim.y * gridDim.z;
    unsigned sum, cnt, mine, sp = 0u;
    for (;;) {
        sum = 0u; cnt = 0u; mine = 0u;
#pragma unroll
        for (unsigned j = 0; j < 16; ++j) { const unsigned c = xb_ld(&bar[XB_XCNT(j)]); sum += c; cnt += (c > 0u) ? 1u : 0u; mine = (j == x) ? c : mine; }
        if (sum == G) break;
        __builtin_amdgcn_s_sleep(1);
        if ((++sp & 255u) == 0u) { if (xb_ld(&bar[XB_TMO])) break; if (sp > XB_SPIN_CAP) { atomicAdd(&bar[XB_TMO], 1u); break; } }
    }
    nloc = mine > 0u ? mine : 1u; nx = cnt > 0u ? cnt : 1u;
}
__device__ __forceinline__ void xcd_barrier(const XcdBarrier& b) {
    asm volatile("s_waitcnt vmcnt(0)" ::: "memory");
    __syncthreads();
    if (threadIdx.x == 0) {
        unsigned* bar = b.bar;
        __builtin_amdgcn_s_waitcnt(0);
        unsigned nloc = b.st[0], nx = b.st[1];
        if (nloc == 0u) { xcd_barrier_complete(bar, b.x, nloc, nx); b.st[0] = nloc; b.st[1] = nx; }
        const unsigned old = xb_add(&bar[XB_XSUB(b.x)], 1u);
        const unsigned gen = old / nloc;
        if (old + 1u == (gen + 1u) * nloc) {
            __builtin_amdgcn_fence(__ATOMIC_RELEASE, "agent");
            asm volatile("s_waitcnt vmcnt(0)" ::: "memory");
            const unsigned og = xb_add(&bar[XB_TOP], 1u);
            const unsigned tg = og / nx;
            if (og + 1u == (tg + 1u) * nx) xb_add(&bar[XB_TOPGEN], 1u);
            else XB_SPIN(xb_ld(&bar[XB_TOPGEN]) == tg, bar);
            __builtin_amdgcn_fence(__ATOMIC_ACQUIRE, "agent");
            xb_add(&bar[XB_XGEN(b.x)], 1u);
            asm volatile("s_waitcnt vmcnt(0)" ::: "memory");
        } else {
            XB_SPIN(xb_ld(&bar[XB_XGEN(b.x)]) == gen, bar);
            __builtin_amdgcn_fence(__ATOMIC_ACQUIRE, "agent");
            asm volatile("s_waitcnt vmcnt(0)" ::: "memory");
        }
    }
    __syncthreads();
}

#ifndef MK_ONE_LAUNCH
#define MK_ONE_LAUNCH 1
#endif
constexpr int NPHASE = 20;
constexpr int RING_BYTES = 131072, MISC_OFF = RING_BYTES + 320, LDS_BYTES = 147456;
static_assert(XCD_BAR_WORDS * 4 <= (int)WS_MOD && att::LDS_BTAB + 12 * att::BT_PITCH * 4 <= RING_BYTES, "maps");

__global__ void __launch_bounds__(NTHREADS, 2) mk_fwd(Args a) {
    extern __shared__ __attribute__((aligned(16))) unsigned char lds[];
    Frame F;
    F.lds = (LAS unsigned char*)lds; F.tid = threadIdx.x; F.lane = F.tid & 63; F.wave = __builtin_amdgcn_readfirstlane(F.tid >> 6); F.G = gridDim.x; F.wg = blockIdx.x;
#pragma unroll
    for (int i = 0; i < 16; ++i) F.in[i] = a.in[i];
    F.X = a.out; F.ws = a.ws; F.mod = (float*)(a.ws + WS_MOD); F.SS = (float*)(a.ws + WS_SS); F.SW = (float*)(a.ws + WS_SW); F.H = (bf16*)(a.ws + WS_H); F.H2 = (bf16*)(a.ws + WS_H2); F.OCAT = (bf16*)(a.ws + WS_OCAT); F.QKVG = (bf16*)(a.ws + WS_BIG); F.ACT = (bf16*)(a.ws + WS_BIG);
    volatile LAS unsigned* MISC = (volatile LAS unsigned*)(F.lds + MISC_OFF);
    if (F.tid < 32) MISC[F.tid] = 0u;
    __syncthreads();
    const int lo = a.ph_lo, hi = a.ph_hi;
    XcdBarrier bar; bar.bar = (unsigned*)(a.ws + WS_CTL); bar.x = 0; bar.st = nullptr;
    if (hi - lo > 1) bar = xcd_barrier_post((unsigned*)(a.ws + WS_CTL), MISC + 8);
    unsigned char* const wb = a.ws + WS_W;
#define PHASE(k, ...) do { if (lo <= (k) && (k) < hi) { __VA_ARGS__; if ((k) + 1 < hi) xcd_barrier(bar); } } while (0)
#define LAYER(l, XIN0, P) \
    PHASE((P) + 0, ph_ffn_up(F, F.H, (const bf16*)(wb + WO_GU0), (l), 0)); \
    PHASE((P) + 1, ph_xupd<true, true>(F, F.ACT, DFF, (const bf16*)(wb + WO_D0), (XIN0), F.X, F.H, (l), 0, (l), 1)); \
    PHASE((P) + 2, ph_inproj(F, (l))); \
    PHASE((P) + 3, ph_attn(F, (l))); \
    PHASE((P) + 4, ph_branch(F)); \
    PHASE((P) + 5, ph_xupd<true, false>(F, F.H, D, (const bf16*)(wb + WO_OUT), F.X, F.X, F.H2, (l), 1, (l), 2)); \
    PHASE((P) + 6, ph_ffn_up(F, F.H2, (const bf16*)(wb + WO_GU1), (l), 2)); \
    PHASE((P) + 7, ph_xupd<((l) + 1 < DEPTH), true>(F, F.ACT, DFF, (const bf16*)(wb + WO_D1), F.X, F.X, F.H, (l), 2, (l) + 1, 0))
    PHASE(0, ph_adaln(F));
    PHASE(1, ph_convert(F, 0); ph_prep0(F));
    LAYER(0, F.in[I_X], 2);
    PHASE(10, ph_convert(F, 1));
    LAYER(1, F.X, 11);
    PHASE(NPHASE - 1, ph_final(F));
#undef LAYER
#undef PHASE
}

extern "C" void kernel_launch(void* const* d_in, const int* in_sizes, int n_in, void* d_out, int out_size, void* d_ws, size_t ws_size, hipStream_t stream) {
    static int grid = 0;
    if (grid == 0) {
        if (n_in != 16 || in_sizes[0] != M * D || out_size != M * D || ws_size < WS_END) { fprintf(stderr, "kernel_launch: unexpected shapes (n_in %d, in0 %d, out %d, ws %zu)\n", n_in, n_in > 0 ? in_sizes[0] : -1, out_size, ws_size); grid = -1; return; }
        int dev = 0, cus = 0, per_cu = 0;
        if (hipGetDevice(&dev) != hipSuccess || hipDeviceGetAttribute(&cus, hipDeviceAttributeMultiprocessorCount, dev) != hipSuccess) { grid = -1; return; }
        if (hipFuncSetAttribute((const void*)mk_fwd, hipFuncAttributeMaxDynamicSharedMemorySize, LDS_BYTES) != hipSuccess) { fprintf(stderr, "kernel_launch: hipFuncSetAttribute failed\n"); grid = -1; return; }
        if (hipOccupancyMaxActiveBlocksPerMultiprocessor(&per_cu, (const void*)mk_fwd, NTHREADS, LDS_BYTES) != hipSuccess || per_cu < 1) { fprintf(stderr, "kernel_launch: occupancy query reports %d workgroups per CU\n", per_cu); (void)hipGetLastError(); grid = -1; return; }
        grid = cus;
    }
    if (grid < 0) return;
    Args a{};
    for (int i = 0; i < 16; ++i) a.in[i] = (const float*)d_in[i];
    a.out = (float*)d_out; a.ws = (unsigned char*)d_ws;
#if MK_ONE_LAUNCH
    (void)hipMemsetAsync((char*)d_ws + WS_CTL, 0, ZERO_BYTES, stream);
    a.ph_lo = 0; a.ph_hi = NPHASE;
    hipLaunchKernelGGL(mk_fwd, dim3(grid), dim3(NTHREADS), LDS_BYTES, stream, a);
#else
    for (int ph = 0; ph < NPHASE; ++ph) { a.ph_lo = ph; a.ph_hi = ph + 1; hipLaunchKernelGGL(mk_fwd, dim3(grid), dim3(NTHREADS), LDS_BYTES, stream, a); }
#endif
}
```

```cpp
#include <hip/hip_runtime.h>
#include <cstdio>
#include <cstdint>

#define LAS __attribute__((address_space(3)))
typedef unsigned short bf16;
typedef float f32x4 __attribute__((ext_vector_type(4)));
typedef unsigned u32x2 __attribute__((ext_vector_type(2)));
typedef unsigned u32x4 __attribute__((ext_vector_type(4)));

constexpr int D = 1024, BATCH = 8, SEQ = 2048, M = BATCH * SEQ, DEPTH = 2, HD = 64;
constexpr int DFF = 2816, DIN = 5632, NADA = 9216;
constexpr int C_QSB = 0, C_KSB = 256, C_VSB = 512, C_QDIL = 768, C_KDIL = 1152, C_VDIL = 1536, C_QSWA = 1920, C_KSWA = 2304, C_VSWA = 2432, C_GATE = 2560;
constexpr int OC = 768;
constexpr float RMS_EPS = 1e-6f;
constexpr float QSCALE = 0.125f * 1.4426950408889634f;
constexpr float LOG2E = 1.4426950408889634f;
constexpr int NTHREADS = 512;

constexpr size_t MiB = 1u << 20;
constexpr size_t WS_CTL = 0, WS_MOD = 65536, ZERO_BYTES = 655360;
constexpr size_t WS_SS = 1 * MiB, WS_SW = MiB + MiB / 2, WS_SW_END = WS_SW + (size_t)DEPTH * 3 * BATCH * DIN * 4;
constexpr size_t WS_W = 4 * MiB, WS_H = 52 * MiB, WS_OCAT = 84 * MiB, WS_BIG = 108 * MiB, WS_H2 = 284 * MiB, WS_END = 316 * MiB;
static_assert(WS_MOD + (size_t)DEPTH * BATCH * NADA * 4 <= ZERO_BYTES && WS_SS + 7 * (size_t)M * 4 <= WS_SW && WS_SW_END <= WS_W, "ws map");

enum { I_X = 0, I_C, I_WADA, I_BADA, I_NG, I_WG, I_WU, I_WD, I_WIN, I_WBSB, I_WBDIL, I_WBSWA, I_WOUT, I_SINKS, I_RELB, I_FG };

struct Args { const float* in[16]; float* out; unsigned char* ws; int ph_lo, ph_hi; };

__device__ __forceinline__ unsigned f2bf(float f) { unsigned u = __builtin_bit_cast(unsigned, f); return (u + 0x7fffu + ((u >> 16) & 1u)) >> 16; }
__device__ __forceinline__ float bf2f(unsigned b) { return __builtin_bit_cast(float, b << 16); }
typedef float f32x2_t __attribute__((ext_vector_type(2))); typedef __bf16 bf16x2_t __attribute__((ext_vector_type(2)));
__device__ __forceinline__ unsigned pk2(float lo, float hi) { const f32x2_t v = {lo, hi}; const bf16x2_t b = __builtin_convertvector(v, bf16x2_t); return __builtin_bit_cast(unsigned, b); }
__device__ __forceinline__ float wave_sum(float v) {
#pragma unroll
    for (int o = 1; o < 64; o <<= 1) v += __shfl_xor(v, o);
    return v;
}
__device__ __forceinline__ float sigmoidf_(float x) { return 1.0f / (1.0f + __expf(-x)); }

struct Frame {
    LAS unsigned char* lds;
    int tid, lane, wave, G, wg;
    const float* in[16];
    float* X;
    float* mod;
    float* SS;
    float* SW;
    bf16 *H, *H2, *OCAT, *QKVG, *ACT;
    unsigned char* ws;
};

__device__ __forceinline__ const float* modp(const Frame& F, int l, int b, int j, int t) { return F.mod + ((size_t)(l * BATCH + b) * NADA) + (j * 3 + t) * D; }

__device__ __forceinline__ float silu_f(float g) { return g * __builtin_amdgcn_rcpf(1.0f + __expf(-g)); }
__device__ __forceinline__ float sigm_f(float g) { return __builtin_amdgcn_rcpf(1.0f + __expf(-g)); }

__device__ __forceinline__ void ph_adaln(Frame& F) {
    { f32x4* z = (f32x4*)(F.ws + WS_SS); const int nz = (int)((WS_SW_END - WS_SS) / 16); for (int i = F.wg * NTHREADS + F.tid; i < nz; i += F.G * NTHREADS) z[i] = (f32x4){0.f, 0.f, 0.f, 0.f}; }
    LAS float* sc = (LAS float*)F.lds; LAS float* red = sc + 8 * 256;
    const float* c = F.in[I_C]; const float* W = F.in[I_WADA]; const float* bb = F.in[I_BADA];
    for (int it = F.wg; it < DEPTH * 36 * 4; it += F.G) {
        const int kq = it & 3, nb = (it >> 2) % 36, l = it / 144;
        for (int i = F.tid; i < 8 * 256; i += NTHREADS) { const float cv = c[(i >> 8) * D + kq * 256 + (i & 255)]; sc[i] = cv * sigm_f(cv); }
        __syncthreads();
        f32x4 acc[8];
#pragma unroll
        for (int b = 0; b < 8; ++b) acc[b] = (f32x4){0.f, 0.f, 0.f, 0.f};
        const float* wp = W + ((size_t)l * D + kq * 256 + F.wave * 32) * NADA + nb * 256 + 4 * F.lane;
#pragma unroll 4
        for (int kk = 0; kk < 32; ++kk) { const f32x4 wv = *(const f32x4*)(wp + (size_t)kk * NADA);
#pragma unroll
            for (int b = 0; b < 8; ++b) acc[b] += sc[b * 256 + F.wave * 32 + kk] * wv; }
#pragma unroll
        for (int b = 0; b < 8; ++b) *(LAS f32x4*)(red + (F.wave * 8 + b) * 256 + 4 * F.lane) = acc[b];
        __syncthreads();
        { const int b = F.tid >> 6, c4 = (F.tid & 63) * 4; f32x4 sum = (f32x4){0.f, 0.f, 0.f, 0.f};
#pragma unroll
          for (int w = 0; w < 8; ++w) sum += *(const LAS f32x4*)(red + (w * 8 + b) * 256 + c4);
          if (kq == 0) sum += *(const f32x4*)(bb + l * NADA + nb * 256 + c4);
          float* dst = F.mod + (size_t)(l * BATCH + b) * NADA + nb * 256 + c4;
          atomicAdd(dst + 0, sum.x); atomicAdd(dst + 1, sum.y); atomicAdd(dst + 2, sum.z); atomicAdd(dst + 3, sum.w); }
        __syncthreads();
    }
}

__device__ __forceinline__ void ph_prep0(Frame& F) {
    const float* xin = F.in[I_X]; const float* g = F.in[I_NG];
    const int gw = F.wg * (NTHREADS / 64) + F.wave, NGW = F.G * (NTHREADS / 64);
    for (int m = gw; m < M; m += NGW) {
        const int b = m / SEQ; const float* sc = modp(F, 0, b, 0, 1);
        const f32x4* xr = (const f32x4*)(xin + (size_t)m * D) + F.lane;
        f32x4 v[4]; float s = 0.f;
#pragma unroll
        for (int i = 0; i < 4; ++i) { v[i] = xr[64 * i]; s += (v[i].x * v[i].x + v[i].y * v[i].y) + (v[i].z * v[i].z + v[i].w * v[i].w); }
        s = wave_sum(s);
        if (F.lane == 0) F.SS[m] = s;
        u32x2* o = (u32x2*)(F.H + (size_t)m * D) + F.lane;
#pragma unroll
        for (int i = 0; i < 4; ++i) {
            const int c0 = 4 * F.lane + 256 * i; const f32x4 gg = *(const f32x4*)(g + c0), ss = *(const f32x4*)(sc + c0);
            const f32x4 y = v[i] * gg * (1.0f + ss);
            u32x2 w; w.x = pk2(y.x, y.y); w.y = pk2(y.z, y.w); o[64 * i] = w;
        }
    }
}
__device__ __forceinline__ void ph_final(Frame& F) {
    const float* g = F.in[I_FG];
    const int gw = F.wg * (NTHREADS / 64) + F.wave, NGW = F.G * (NTHREADS / 64);
    for (int m = gw; m < M; m += NGW) {
        f32x4* xr = (f32x4*)(F.X + (size_t)m * D) + F.lane;
        f32x4 v[4]; float s = 0.f;
#pragma unroll
        for (int i = 0; i < 4; ++i) { v[i] = xr[64 * i]; s += (v[i].x * v[i].x + v[i].y * v[i].y) + (v[i].z * v[i].z + v[i].w * v[i].w); }
        const float rstd = 1.0f / sqrtf(wave_sum(s) * (1.f / D) + RMS_EPS);
#pragma unroll
        for (int i = 0; i < 4; ++i) { const f32x4 gg = *(const f32x4*)(g + 4 * F.lane + 256 * i); xr[64 * i] = v[i] * rstd * gg; }
    }
}

__device__ __forceinline__ int t5_bucket(int n) {
    if (n < 16) return n;
    int b = 16;
    b += (n >= 22); b += (n >= 30); b += (n >= 40); b += (n >= 54); b += (n >= 73); b += (n >= 99); b += (n >= 134); b += (n >= 182);
    b += (n >= 246); b += (n >= 332); b += (n >= 450); b += (n >= 609); b += (n >= 825); b += (n >= 1117); b += (n >= 1513); b += (n >= 2048);
    return b > 31 ? 31 : b;
}
constexpr size_t WO_GU0 = 0, WO_D0 = 11 * MiB, WO_GU1 = 16 * MiB + MiB / 2, WO_D1 = 27 * MiB + MiB / 2, WO_IN = 33 * MiB, WO_BR = 44 * MiB, WO_OUT = 45 * MiB + MiB / 2;
static_assert(WS_W + WO_OUT + 2 * MiB <= WS_H, "weight copies fit below H");
__host__ __device__ __forceinline__ int perm32(int rho) { const int n = rho >> 4, i = rho & 15; return 8 * (i >> 2) + 4 * n + (i & 3); }

template <bool SW>
__device__ __forceinline__ void cv_item(const float* src, int Nsrc, int srccol, bf16* dst, int Kd, int prow0, int ks0, int kd0, LAS float* scr, int lane, const float* shift, float* sw) {
#pragma unroll 8
    for (int i = 0; i < 32; ++i) { const int kk = 2 * i + (lane >> 5); scr[kk * 33 + (lane & 31)] = src[(size_t)(ks0 + kk) * Nsrc + srccol]; }
    LAS float* sh = scr + 64 * 33;
    if (SW) {
#pragma unroll
        for (int i = 0; i < 8; ++i) sh[i * 64 + lane] = shift[(size_t)i * NADA + ks0 + lane];
    }
    asm volatile("s_waitcnt lgkmcnt(0)" ::: "memory");
    const int c = lane & 7;
#pragma unroll
    for (int j = 0; j < 4; ++j) { const int n = (lane >> 3) + 8 * j; const LAS float* sp = scr + (8 * c) * 33 + n;
        u32x4 o; o.x = pk2(sp[0 * 33], sp[1 * 33]); o.y = pk2(sp[2 * 33], sp[3 * 33]); o.z = pk2(sp[4 * 33], sp[5 * 33]); o.w = pk2(sp[6 * 33], sp[7 * 33]);
        *(u32x4*)(dst + (size_t)(prow0 + n) * Kd + kd0 + 8 * c) = o; }
    if (SW) {
        const int n = lane & 31, bh = lane >> 5; float acc[4] = {0.f, 0.f, 0.f, 0.f};
#pragma unroll 4
        for (int k4 = 0; k4 < 16; ++k4) { const float t0 = scr[(4 * k4) * 33 + n], t1 = scr[(4 * k4 + 1) * 33 + n], t2 = scr[(4 * k4 + 2) * 33 + n], t3 = scr[(4 * k4 + 3) * 33 + n];
#pragma unroll
            for (int b4 = 0; b4 < 4; ++b4) { const f32x4 sv = *(const LAS f32x4*)(sh + (bh * 4 + b4) * 64 + 4 * k4); acc[b4] += (t0 * sv.x + t1 * sv.y) + (t2 * sv.z + t3 * sv.w); } }
#pragma unroll
        for (int b4 = 0; b4 < 4; ++b4) atomicAdd(sw + (size_t)(bh * 4 + b4) * DIN + prow0 + n, acc[b4]);
    }
    asm volatile("s_waitcnt lgkmcnt(0)" ::: "memory");
}
__device__ __forceinline__ void ph_convert(Frame& F, int l) {
    LAS float* scr = (LAS float*)(F.lds + F.wave * 16384);
    const int gw = F.wg * (NTHREADS / 64) + F.wave, NGW = F.G * (NTHREADS / 64);
    unsigned char* wb = F.ws + WS_W;
    constexpr int I_GU = 16 * 176, I_D = 44 * 32, I_IN = 16 * 176, I_B0 = 4 * 32, I_B1 = 2 * 32, I_B2 = 6 * 32, I_O = 16 * 32;
    constexpr int NIT = 2 * I_GU + 2 * I_D + I_IN + I_B0 + I_B1 + I_B2 + I_O;
    const int r = F.lane & 31;
    const float* shl = F.mod + (size_t)l * BATCH * NADA;
    float* swl = F.SW + (size_t)l * 3 * BATCH * DIN;
    for (int it = gw; it < NIT; it += NGW) {
        int x = it;
        if (x < 2 * I_GU) { const int f = x / I_GU; x %= I_GU; const int kb = x / 176, nb = x % 176, p0 = nb * 32, t = p0 >> 8, bj = (p0 >> 7) & 1, wc = (p0 >> 5) & 3;
            const float* src = F.in[bj ? I_WU : I_WG] + (size_t)(l * 2 + f) * D * DFF;
            cv_item<true>(src, DFF, 128 * t + 32 * wc + perm32(r), (bf16*)(wb + (f ? WO_GU1 : WO_GU0)), D, p0, kb * 64, kb * 64, scr, F.lane, shl + (f ? 6 : 0) * D, swl + (f ? 2 : 0) * BATCH * DIN); continue; }
        x -= 2 * I_GU;
        if (x < I_IN) { const int kb = x / 176, nb = x % 176;
            cv_item<true>(F.in[I_WIN] + (size_t)l * D * DIN, DIN, nb * 32 + perm32(r), (bf16*)(wb + WO_IN), D, nb * 32, kb * 64, kb * 64, scr, F.lane, shl + 3 * D, swl + BATCH * DIN); continue; }
        x -= I_IN;
        if (x < 2 * I_D) { const int f = x / I_D; x %= I_D; const int kb = x / 32, nb = x % 32;
            cv_item<false>(F.in[I_WD] + (size_t)(l * 2 + f) * DFF * D, D, nb * 32 + r, (bf16*)(wb + (f ? WO_D1 : WO_D0)), DFF, nb * 32, kb * 64, kb * 64, scr, F.lane, nullptr, nullptr); continue; }
        x -= 2 * I_D;
        if (x < I_B0) { const int kb = x / 32, nb = x % 32;
            cv_item<false>(F.in[I_WBSB] + (size_t)l * 256 * D, D, nb * 32 + perm32(r), (bf16*)(wb + WO_BR), OC, nb * 32, kb * 64, kb * 64, scr, F.lane, nullptr, nullptr); continue; }
        x -= I_B0;
        if (x < I_B1) { const int kb = x / 32, nb = x % 32;
            cv_item<false>(F.in[I_WBDIL] + (size_t)l * 128 * D, D, nb * 32 + perm32(r), (bf16*)(wb + WO_BR), OC, nb * 32, kb * 64, 256 + kb * 64, scr, F.lane, nullptr, nullptr); continue; }
        x -= I_B1;
        if (x < I_B2) { const int kb = x / 32, nb = x % 32;
            cv_item<false>(F.in[I_WBSWA] + (size_t)l * 384 * D, D, nb * 32 + perm32(r), (bf16*)(wb + WO_BR), OC, nb * 32, kb * 64, 384 + kb * 64, scr, F.lane, nullptr, nullptr); continue; }
        x -= I_B2;
        { const int kb = x / 32, nb = x % 32;
            cv_item<false>(F.in[I_WOUT] + (size_t)l * D * D, D, nb * 32 + r, (bf16*)(wb + WO_OUT), D, nb * 32, kb * 64, kb * 64, scr, F.lane, nullptr, nullptr); }
    }
}

namespace pg8 {
typedef short bf16x8 __attribute__((ext_vector_type(8)));
constexpr int BM = 256, BK = 64, HALF = 128, HTB = HALF * BK * 2, STAGE_BYTES = 8 * HTB, NXCD = 8, WGM = 4;
__host__ __device__ __forceinline__ int lds_byte(int r, int c) { const int st = (r >> 4) * 2 + (c >> 5), rr = r & 15, cc = c & 31, ob = rr * 64 + cc * 2; return st * 1024 + (ob ^ (((ob >> 9) & 1) << 5)); }
__host__ __device__ __forceinline__ void stage_rc(int b, int& R, int& C) { const int st = b / 1024, sb = b % 1024, swz = sb ^ (((sb >> 9) & 1) << 5); R = (st >> 1) * 16 + swz / 64; C = (st & 1) * 32 + (swz % 64) / 2; }
struct Unit { int pm, pn, br, hf; };
struct Gemm { const bf16* A; const bf16* Bt; int ld; };
template <int NBR> struct StaticOrderT {
    int nM, nN, nwg, G, c; bool split;
    __device__ void init(int M_, int N_, int G_, int c_, bool split_ = false) { nM = M_ / BM; nN = N_ / BM; nwg = nM * nN; G = G_; c = c_; split = split_; }
    __device__ bool next(int i, Unit& u) const {
        const int ti = i / NBR, full = nwg / G, R = nwg - full * G;
        int wgid; u.hf = 0;
        if (ti < full) wgid = ti * G + c;
        else if (ti == full && R > 0) {
            if (split && 2 * R <= G) { const bool x16 = (G & 15) == 0;
                const int t = x16 ? 8 * (c >> 4) + (c & 7) : (c >> 1);
                if (t >= R) return false; wgid = full * G + t; u.hf = 1 + (x16 ? ((c >> 3) & 1) : (c & 1)); }
            else { if (c >= R) return false; wgid = full * G + c; } }
        else return false;
        { const int q = nwg / NXCD, r = nwg % NXCD, xcd = wgid % NXCD, off = wgid / NXCD; wgid = (xcd < r ? xcd * (q + 1) : r * (q + 1) + (xcd - r) * q) + off; }
        const int nig = WGM * nN, gid = wgid / nig, fm = gid * WGM, gsz = (nM - fm) < WGM ? (nM - fm) : WGM;
        u.pm = fm + ((wgid % nig) % gsz); u.pn = (wgid % nig) / gsz; u.br = i % NBR; return true;
    }
};
struct OrderK : StaticOrderT<1> {
    int ntiles;
    __device__ __forceinline__ int nt(const Unit&) const { return ntiles; }
    __device__ __forceinline__ int kofs(const Unit&) const { return 0; }
};
struct OrderBr : StaticOrderT<3> {
    __device__ __forceinline__ int nt(const Unit& u) const { return u.br == 0 ? 4 : (u.br == 1 ? 2 : 6); }
    __device__ __forceinline__ int kofs(const Unit& u) const { return u.br == 0 ? 0 : (u.br == 1 ? 256 : 384); }
};

template <class Epi, class Sched, bool ALIGN_EPI, bool SP2>
__device__ __forceinline__ void gemm_phase(LAS unsigned char* lds, const Gemm g, const Sched& S, const Epi& E) {
    const int tid = threadIdx.x, wid = __builtin_amdgcn_readfirstlane(tid >> 6), lane = tid & 63, wr = wid >> 2, wc = wid & 3, fr = lane & 15, fq = lane >> 4;
    const int LD = g.ld;
    unsigned voff[2];
#pragma unroll
    for (int i = 0; i < 2; ++i) { int R, C; stage_rc(tid * 16 + i * 8192, R, C); voff[i] = (unsigned)(R * LD + C) * 2u; }
    const size_t kstep = (size_t)(BK * 2);
    const size_t hstep = (size_t)HALF * LD * 2;
    const size_t tstep = 2 * hstep;
    const unsigned ldsw = (unsigned)wid * 1024u;
    const int aoff = lds_byte(wr * 64 + fr, fq * 8), boff = lds_byte(wc * 32 + fr, fq * 8);
#define PG8_SA(b, h) (((b) * 2 + (h)) * HTB)
#define PG8_SB(b, h) ((4 + (b) * 2 + (h)) * HTB)
#define PG8_STAGE(bufoff, gbase) do { _Pragma("unroll") for (int _i = 0; _i < 2; ++_i) \
        __builtin_amdgcn_global_load_lds((const unsigned*)((const char*)(gbase) + voff[_i]), (LAS unsigned*)(lds + (bufoff) + ldsw + _i * 8192), 16, 0, 0); } while (0)
#define PG8_LDA(dst, b, h) do { _Pragma("unroll") for (int m = 0; m < 4; ++m) _Pragma("unroll") for (int k = 0; k < 2; ++k) dst[m][k] = *(const LAS bf16x8*)(lds + PG8_SA(b, h) + aoff + m * 2048 + k * 1024); } while (0)
#define PG8_LDB(dst, b, h) do { _Pragma("unroll") for (int n = 0; n < 2; ++n) _Pragma("unroll") for (int k = 0; k < 2; ++k) dst[n][k] = *(const LAS bf16x8*)(lds + PG8_SB(b, h) + boff + n * 2048 + k * 1024); } while (0)
#define PG8_MMA(ai, bj, At, Bt) do { __builtin_amdgcn_s_setprio(1); _Pragma("unroll") for (int m = 0; m < 4; ++m) _Pragma("unroll") for (int n = 0; n < 2; ++n) _Pragma("unroll") for (int k = 0; k < 2; ++k) \
        acc[ai][bj][m][n] = __builtin_amdgcn_mfma_f32_16x16x32_bf16(Bt[n][k], At[m][k], acc[ai][bj][m][n], 0, 0, 0); __builtin_amdgcn_s_setprio(0); } while (0)
#define PG8_WAIT_V(n) asm volatile("s_waitcnt vmcnt(" #n ")" ::: "memory")
#define PG8_WAIT_L(n) asm volatile("s_waitcnt lgkmcnt(" #n ")" ::: "memory")
#define PG8_BAR __builtin_amdgcn_s_barrier()
#define PG8_SCHED __builtin_amdgcn_sched_barrier(0)
#define PG8_ZERO() do { _Pragma("unroll") for (int a_ = 0; a_ < 2; ++a_) _Pragma("unroll") for (int b_ = 0; b_ < 2; ++b_) _Pragma("unroll") for (int m_ = 0; m_ < 4; ++m_) _Pragma("unroll") for (int n_ = 0; n_ < 2; ++n_) acc[a_][b_][m_][n_] = (f32x4){0.f, 0.f, 0.f, 0.f}; } while (0)
    Unit cur, nxt; int ui = 0;
    if (!S.next(0, cur)) return;
    f32x4 acc[2][2][4][2];
    PG8_ZERO();
    bf16x8 At[4][2], B0[2][2], B1[2][2];
    const char* cA = (const char*)g.A + (size_t)cur.pm * tstep + (size_t)S.kofs(cur) * 2 + (cur.hf == 2 ? hstep : 0); const char* cB = (const char*)g.Bt + (size_t)cur.pn * tstep + (size_t)S.kofs(cur) * 2;
    if constexpr (SP2) {
        PG8_STAGE(PG8_SB(0, 0), cB); PG8_STAGE(PG8_SB(0, 1), cB + hstep); PG8_STAGE(PG8_SA(0, 0), cA); PG8_STAGE(PG8_SA(0, 1), cA + hstep);
        if (wr == 1) PG8_BAR;
        PG8_WAIT_V(2); PG8_BAR;
        PG8_STAGE(PG8_SB(1, 0), cB + kstep); PG8_STAGE(PG8_SA(1, 0), cA + kstep); PG8_STAGE(PG8_SB(1, 1), cB + hstep + kstep);
        PG8_WAIT_V(6); PG8_BAR;
    } else {
        PG8_STAGE(PG8_SB(0, 0), cB); PG8_STAGE(PG8_SA(0, 0), cA); PG8_STAGE(PG8_SB(0, 1), cB + hstep); PG8_STAGE(PG8_SA(0, 1), cA + hstep);
        if (wr == 1) PG8_BAR;
        PG8_WAIT_V(4); PG8_BAR;
        PG8_STAGE(PG8_SB(1, 0), cB + kstep); PG8_STAGE(PG8_SA(1, 0), cA + kstep); PG8_STAGE(PG8_SB(1, 1), cB + hstep + kstep);
        PG8_WAIT_V(6); PG8_BAR;
    }
    for (;;) {
        const bool has_next = S.next(ui + 1, nxt);
        const char* nA = has_next ? (const char*)g.A + (size_t)nxt.pm * tstep + (size_t)S.kofs(nxt) * 2 + (nxt.hf == 2 ? hstep : 0) : cA; const char* nB = has_next ? (const char*)g.Bt + (size_t)nxt.pn * tstep + (size_t)S.kofs(nxt) * 2 : cB;
        const int nt = S.nt(cur); const bool whole = cur.hf == 0;
        for (int t = 0; t < nt; t += 2) {
            const bool last = (t == nt - 2);
            const char* a1 = cA + (size_t)(t + 1) * kstep;
            const char* a2 = last ? nA : cA + (size_t)(t + 2) * kstep; const char* b2 = last ? nB : cB + (size_t)(t + 2) * kstep;
            const char* a3 = a2 + kstep; const char* b3 = b2 + kstep;
            if constexpr (SP2) {
            PG8_LDB(B0, 0, 0); PG8_LDB(B1, 0, 1); PG8_SCHED; PG8_LDA(At, 0, 0); PG8_STAGE(PG8_SA(1, 1), a1 + hstep);
            PG8_WAIT_V(8); PG8_WAIT_L(0); PG8_BAR; PG8_MMA(0, 0, At, B0); PG8_MMA(0, 1, At, B1); PG8_BAR; PG8_SCHED;
            if (whole) PG8_LDA(At, 0, 1); PG8_STAGE(PG8_SB(0, 0), b2); PG8_STAGE(PG8_SB(0, 1), b2 + hstep); PG8_STAGE(PG8_SA(0, 0), a2);
            PG8_WAIT_V(8); PG8_WAIT_L(0); PG8_BAR; if (whole) { PG8_MMA(1, 0, At, B0); PG8_MMA(1, 1, At, B1); } PG8_BAR; PG8_SCHED;
            PG8_LDB(B0, 1, 0); PG8_LDB(B1, 1, 1); PG8_SCHED; PG8_LDA(At, 1, 0); PG8_STAGE(PG8_SA(0, 1), a2 + hstep);
            PG8_WAIT_V(8); PG8_WAIT_L(0); PG8_BAR; PG8_MMA(0, 0, At, B0); PG8_MMA(0, 1, At, B1); PG8_BAR; PG8_SCHED;
            if (whole) PG8_LDA(At, 1, 1); PG8_STAGE(PG8_SB(1, 0), b3); PG8_STAGE(PG8_SB(1, 1), b3 + hstep); PG8_STAGE(PG8_SA(1, 0), a3);
            PG8_WAIT_V(8); PG8_WAIT_L(0); PG8_BAR; if (whole) { PG8_MMA(1, 0, At, B0); PG8_MMA(1, 1, At, B1); } PG8_BAR; PG8_SCHED;
            } else {
            PG8_LDB(B0, 0, 0); PG8_SCHED; PG8_LDA(At, 0, 0); PG8_STAGE(PG8_SA(1, 1), a1 + hstep);
            PG8_WAIT_L(8); PG8_BAR; PG8_WAIT_L(0); PG8_MMA(0, 0, At, B0); PG8_BAR; PG8_SCHED;
            PG8_LDB(B1, 0, 1); PG8_STAGE(PG8_SB(0, 0), b2);
            PG8_BAR; PG8_WAIT_L(0); PG8_MMA(0, 1, At, B1); PG8_BAR;
            PG8_LDA(At, 0, 1); PG8_STAGE(PG8_SA(0, 0), a2);
            PG8_BAR; PG8_WAIT_L(0); PG8_MMA(1, 0, At, B0); PG8_BAR; PG8_SCHED;
            PG8_STAGE(PG8_SB(0, 1), b2 + hstep);
            PG8_WAIT_V(6); PG8_BAR; PG8_MMA(1, 1, At, B1); PG8_BAR;
            PG8_LDB(B0, 1, 0); PG8_SCHED; PG8_LDA(At, 1, 0); PG8_STAGE(PG8_SA(0, 1), a2 + hstep);
            PG8_WAIT_L(8); PG8_BAR; PG8_WAIT_L(0); PG8_MMA(0, 0, At, B0); PG8_BAR; PG8_SCHED;
            PG8_LDB(B1, 1, 1); PG8_STAGE(PG8_SB(1, 0), b3);
            PG8_BAR; PG8_WAIT_L(0); PG8_MMA(0, 1, At, B1); PG8_BAR;
            PG8_LDA(At, 1, 1); PG8_STAGE(PG8_SA(1, 0), a3);
            PG8_BAR; PG8_WAIT_L(0); PG8_MMA(1, 0, At, B0); PG8_BAR; PG8_SCHED;
            PG8_STAGE(PG8_SB(1, 1), b3 + hstep);
            PG8_WAIT_V(6); PG8_BAR; PG8_MMA(1, 1, At, B1); PG8_BAR;
            }
        }
        if constexpr (ALIGN_EPI) { if (wr == 0) PG8_BAR; }
        const bool keep = E(acc, cur, wr, wc, fr, fq);
        if (!has_next) break;
        if (!keep) PG8_ZERO();
        cur = nxt; cA = nA; cB = nB; ++ui;
        if constexpr (ALIGN_EPI) { if (wr == 1) PG8_BAR; }
    }
    PG8_WAIT_V(0);
    if constexpr (!ALIGN_EPI) { if (wr == 0) PG8_BAR; }
    PG8_BAR;
#undef PG8_SA
#undef PG8_SB
#undef PG8_STAGE
#undef PG8_LDA
#undef PG8_LDB
#undef PG8_MMA
#undef PG8_WAIT_V
#undef PG8_WAIT_L
#undef PG8_BAR
#undef PG8_SCHED
#undef PG8_ZERO
}

template <bool NEXT, bool HALFCS> struct EpiXupd {
    const float* xin; float* xout; const float* gate0;
    bf16* hout; const float* ng; const float* nscale0; float* ss;
    __device__ __forceinline__ bool operator()(f32x4 (&acc)[2][2][4][2], const Unit& u, int wr, int wc, int fr, int fq) const {
        const float* const xin = this->xin; float* const xout = this->xout; const float* const gate0 = this->gate0; constexpr float cs = HALFCS ? 0.5f : 1.0f;
        bf16* const hout = this->hout; const float* const ng = this->ng; const float* const nscale0 = this->nscale0; float* const ss = this->ss;
        const int row0 = u.pm * BM + wr * 64 + fr, col0 = u.pn * BM + wc * 32 + 4 * fq; const int b = u.pm >> 3;
        const float* gp = gate0 + (size_t)b * NADA + col0;
        { f32x4 cv[2][2];
#pragma unroll
          for (int bj = 0; bj < 2; ++bj)
#pragma unroll
              for (int n = 0; n < 2; ++n) cv[bj][n] = *(const f32x4*)(gp + bj * HALF + n * 16) * cs;
#pragma unroll
          for (int ai = 0; ai < 2; ++ai)
#pragma unroll
              for (int bj = 0; bj < 2; ++bj)
#pragma unroll
                  for (int m = 0; m < 4; ++m)
#pragma unroll
                      for (int n = 0; n < 2; ++n) acc[ai][bj][m][n] *= cv[bj][n]; }
        f32x4 gs[2][2];
        if (NEXT) { f32x4 t0[2][2], t1[2][2];
#pragma unroll
          for (int bj = 0; bj < 2; ++bj)
#pragma unroll
              for (int n = 0; n < 2; ++n) { t0[bj][n] = *(const f32x4*)(ng + col0 + bj * HALF + n * 16); t1[bj][n] = *(const f32x4*)(nscale0 + (size_t)b * NADA + col0 + bj * HALF + n * 16); }
#pragma unroll
          for (int bj = 0; bj < 2; ++bj)
#pragma unroll
              for (int n = 0; n < 2; ++n) gs[bj][n] = t0[bj][n] * (1.0f + t1[bj][n]); }
        f32x4 xv[3][2][2];
#define XU_LOAD(g) do { _Pragma("unroll") for (int bj = 0; bj < 2; ++bj) _Pragma("unroll") for (int n = 0; n < 2; ++n) \
            xv[(g) % 3][bj][n] = *(const f32x4*)(xin + (size_t)(row0 + ((g) >> 2) * HALF + ((g) & 3) * 16) * D + col0 + bj * HALF + n * 16); } while (0)
        XU_LOAD(0); XU_LOAD(1);
#pragma unroll
        for (int g = 0; g < 8; ++g) {
            if (g + 2 < 8) XU_LOAD(g + 2);
            asm volatile("" ::: "memory");
            const int ai = g >> 2, m = g & 3; const int row = row0 + ai * HALF + m * 16; const size_t off = (size_t)row * D + col0; float sq = 0.f;
#pragma unroll
            for (int bj = 0; bj < 2; ++bj)
#pragma unroll
                for (int n = 0; n < 2; ++n) { const f32x4 xn = xv[g % 3][bj][n] + acc[ai][bj][m][n];
                    *(f32x4*)(xout + off + bj * HALF + n * 16) = xn;
                    if (NEXT) { sq += (xn.x * xn.x + xn.y * xn.y) + (xn.z * xn.z + xn.w * xn.w); const f32x4 hv = xn * gs[bj][n];
                        u32x2 w; w.x = pk2(hv.x, hv.y); w.y = pk2(hv.z, hv.w); *(u32x2*)(hout + off + bj * HALF + n * 16) = w; } }
            if (NEXT) { sq += __shfl_xor(sq, 16); sq += __shfl_xor(sq, 32); if (fq == 0) atomicAdd(ss + row, sq); }
            asm volatile("" ::: "memory");
        }
#undef XU_LOAD
        return false;
    }
};
struct EpiSwiglu {
    bf16* act; const float* ss; const float* sw0;
    __device__ __forceinline__ bool operator()(f32x4 (&acc)[2][2][4][2], const Unit& u, int wr, int wc, int fr, int fq) const {
        const int row0 = u.pm * BM + (u.hf == 2 ? HALF : 0) + wr * 64 + fr, col0 = u.pn * HALF + wc * 32 + 8 * fq;
        const float* sp = sw0 + (size_t)(u.pm >> 3) * DIN + u.pn * BM + wc * 32 + 4 * fq;
        f32x4 sv[2][2]; float sq[2][4];
#pragma unroll
        for (int bj = 0; bj < 2; ++bj)
#pragma unroll
            for (int n = 0; n < 2; ++n) sv[bj][n] = *(const f32x4*)(sp + bj * HALF + n * 16);
#pragma unroll
        for (int ai = 0; ai < 2; ++ai)
#pragma unroll
            for (int m = 0; m < 4; ++m) sq[ai][m] = ss[row0 + ((ai == 1 && u.hf != 0) ? 0 : ai) * HALF + m * 16];
        asm volatile("" ::: "memory");
#pragma unroll
        for (int ai = 0; ai < 2; ++ai) { if (ai == 1 && u.hf != 0) break;
#pragma unroll
            for (int m = 0; m < 4; ++m) {
                const int row = row0 + ai * HALF + m * 16; const float rs = __builtin_amdgcn_rsqf(sq[ai][m] * (1.0f / D) + RMS_EPS);
                const f32x4 g0 = acc[ai][0][m][0] * rs + sv[0][0], g1 = acc[ai][0][m][1] * rs + sv[0][1], u0 = acc[ai][1][m][0] * rs + sv[1][0], u1 = acc[ai][1][m][1] * rs + sv[1][1];
                u32x4 w;
                w.x = pk2(silu_f(g0[0]) * u0[0], silu_f(g0[1]) * u0[1]); w.y = pk2(silu_f(g0[2]) * u0[2], silu_f(g0[3]) * u0[3]);
                w.z = pk2(silu_f(g1[0]) * u1[0], silu_f(g1[1]) * u1[1]); w.w = pk2(silu_f(g1[2]) * u1[2], silu_f(g1[3]) * u1[3]);
                *(u32x4*)(act + (size_t)row * DFF + col0) = w;
            } }
        return false;
    }
};
struct EpiQkvg {
    bf16* out; const float* ss; const float* sw0;
    __device__ __forceinline__ bool operator()(f32x4 (&acc)[2][2][4][2], const Unit& u, int wr, int wc, int fr, int fq) const {
        const int row0 = u.pm * BM + (u.hf == 2 ? HALF : 0) + wr * 64 + fr; const int nai = u.hf != 0 ? 1 : 2;
        const float* sp = sw0 + (size_t)(u.pm >> 3) * DIN + u.pn * BM + wc * 32 + 4 * fq;
        float rs[2][4]; f32x4 sv[2][2];
#pragma unroll
        for (int bj = 0; bj < 2; ++bj) { sv[bj][0] = *(const f32x4*)(sp + bj * HALF); sv[bj][1] = *(const f32x4*)(sp + bj * HALF + 16); }
#pragma unroll
        for (int ai = 0; ai < 2; ++ai)
#pragma unroll
            for (int m = 0; m < 4; ++m) rs[ai][m] = ss[row0 + (ai < nai ? ai : 0) * HALF + m * 16];
        asm volatile("" ::: "memory");
#pragma unroll
        for (int ai = 0; ai < 2; ++ai)
#pragma unroll
            for (int m = 0; m < 4; ++m) rs[ai][m] = __builtin_amdgcn_rsqf(rs[ai][m] * (1.0f / D) + RMS_EPS);
#pragma unroll
        for (int bj = 0; bj < 2; ++bj) {
            const int c = u.pn * BM + bj * HALF;
            const bool isq = (c < C_KSB) || (c >= C_QDIL && c < C_KDIL) || (c >= C_QSWA && c < C_KSWA), isg = c >= C_GATE;
            const int col0 = c + wc * 32 + 8 * fq;
            const f32x4 s0 = sv[bj][0], s1 = sv[bj][1];
#pragma unroll
            for (int ai = 0; ai < 2; ++ai) { if (ai >= nai) break;
#pragma unroll
                for (int m = 0; m < 4; ++m) {
                    f32x4 v0 = acc[ai][bj][m][0] * rs[ai][m] + s0, v1 = acc[ai][bj][m][1] * rs[ai][m] + s1;
                    if (isq) { v0 = v0 * QSCALE; v1 = v1 * QSCALE; }
                    if (isg) {
#pragma unroll
                        for (int e = 0; e < 4; ++e) { v0[e] = sigm_f(v0[e]); v1[e] = sigm_f(v1[e]); } }
                    u32x4 w; w.x = pk2(v0[0], v0[1]); w.y = pk2(v0[2], v0[3]); w.z = pk2(v1[0], v1[1]); w.w = pk2(v1[2], v1[3]);
                    *(u32x4*)(out + (size_t)(row0 + ai * HALF + m * 16) * DIN + col0) = w;
                } }
        }
        return false;
    }
};
struct EpiBranch {
    const bf16* gates;
    bf16* out;
    __device__ __forceinline__ bool operator()(f32x4 (&acc)[2][2][4][2], const Unit& u, int wr, int wc, int fr, int fq) const {
        const int row0 = u.pm * BM + wr * 64 + fr; const int br = u.br;
#pragma unroll
        for (int ai = 0; ai < 2; ++ai) {
            u32x4 sc[4][2], sn[4][2];
#pragma unroll
            for (int m = 0; m < 4; ++m)
#pragma unroll
                for (int bj = 0; bj < 2; ++bj) { const size_t go = (size_t)(row0 + ai * HALF + m * 16) * DIN + u.pn * BM + bj * HALF + wc * 32 + 8 * fq;
                    sc[m][bj] = *(const u32x4*)(gates + go + br * D); if (br < 2) sn[m][bj] = *(const u32x4*)(gates + go + (br + 1) * D); else sn[m][bj] = sc[m][bj]; }
            asm volatile("" ::: "memory");
#pragma unroll
            for (int m = 0; m < 4; ++m)
#pragma unroll
                for (int bj = 0; bj < 2; ++bj) {
                    const int row = row0 + ai * HALF + m * 16, col0 = u.pn * BM + bj * HALF + wc * 32 + 8 * fq;
                    const u32x4 c4 = sc[m][bj], n4 = sn[m][bj];
                    float f[8] = {bf2f(c4.x & 0xffffu), bf2f(c4.x >> 16), bf2f(c4.y & 0xffffu), bf2f(c4.y >> 16), bf2f(c4.z & 0xffffu), bf2f(c4.z >> 16), bf2f(c4.w & 0xffffu), bf2f(c4.w >> 16)};
                    if (br < 2) {
                        const float d[8] = {bf2f(n4.x & 0xffffu), bf2f(n4.x >> 16), bf2f(n4.y & 0xffffu), bf2f(n4.y >> 16), bf2f(n4.z & 0xffffu), bf2f(n4.z >> 16), bf2f(n4.w & 0xffffu), bf2f(n4.w >> 16)};
#pragma unroll
                        for (int e = 0; e < 8; ++e) f[e] = f[e] * __builtin_amdgcn_rcpf(fmaxf(d[e], 1e-30f));
                    }
                    f32x4 v0 = acc[ai][bj][m][0], v1 = acc[ai][bj][m][1];
                    v0[0] *= f[0]; v0[1] *= f[1]; v0[2] *= f[2]; v0[3] *= f[3]; v1[0] *= f[4]; v1[1] *= f[5]; v1[2] *= f[6]; v1[3] *= f[7];
                    if (br < 2) { acc[ai][bj][m][0] = v0; acc[ai][bj][m][1] = v1; }
                    else { u32x4 w; w.x = pk2(v0[0], v0[1]); w.y = pk2(v0[2], v0[3]); w.z = pk2(v1[0], v1[1]); w.w = pk2(v1[2], v1[3]); *(u32x4*)(out + (size_t)row * D + col0) = w; }
                }
            asm volatile("" ::: "memory");
        }
        return br < 2;
    }
};
}

template <bool NEXT, bool HALFCS>
__device__ __forceinline__ void ph_xupd(Frame& F, const bf16* A, int K, const bf16* Bt, const float* xin, float* xout, bf16* hout, int l, int j, int nl, int nj) {
    pg8::Gemm g{A, Bt, K}; pg8::OrderK S; S.init(M, D, F.G, F.wg); S.ntiles = K / 64;
    const float* gate0 = F.mod + (size_t)l * BATCH * NADA + (j * 3 + 2) * D;
    pg8::EpiXupd<NEXT, HALFCS> E{xin, xout, gate0, NEXT ? hout : nullptr, NEXT ? F.in[I_NG] + (nl * 3 + nj) * D : nullptr, NEXT ? F.mod + (size_t)nl * BATCH * NADA + (nj * 3 + 1) * D : nullptr, NEXT ? F.SS + (size_t)(nl * 3 + nj) * M : nullptr};
    pg8::gemm_phase<pg8::EpiXupd<NEXT, HALFCS>, pg8::OrderK, false, true>(F.lds, g, S, E);
}
__device__ __forceinline__ void ph_ffn_up(Frame& F, const bf16* A, const bf16* Bt, int l, int j) {
    pg8::Gemm g{A, Bt, D}; pg8::OrderK S; S.init(M, 2 * DFF, F.G, F.wg, true); S.ntiles = D / 64;
    pg8::EpiSwiglu E{F.ACT, F.SS + (size_t)(l * 3 + j) * M, F.SW + (size_t)(l * 3 + j) * BATCH * DIN};
    pg8::gemm_phase<pg8::EpiSwiglu, pg8::OrderK, true, true>(F.lds, g, S, E);
}
__device__ __forceinline__ void ph_inproj(Frame& F, int l) {
    pg8::Gemm g{F.H, (const bf16*)(F.ws + WS_W + WO_IN), D}; pg8::OrderK S; S.init(M, DIN, F.G, F.wg, true); S.ntiles = D / 64;
    pg8::EpiQkvg E{F.QKVG, F.SS + (size_t)(l * 3 + 1) * M, F.SW + (size_t)(l * 3 + 1) * BATCH * DIN};
    pg8::gemm_phase<pg8::EpiQkvg, pg8::OrderK, true, true>(F.lds, g, S, E);
}
__device__ __forceinline__ void ph_branch(Frame& F) {
    pg8::Gemm g{F.OCAT, (const bf16*)(F.ws + WS_W + WO_BR), OC}; pg8::OrderBr S; S.init(M, D, F.G, F.wg);
    pg8::EpiBranch E{F.QKVG + C_GATE, F.H};
    pg8::gemm_phase<pg8::EpiBranch, pg8::OrderBr, true, true>(F.lds, g, S, E);
}

namespace att {
typedef float f32x16 __attribute__((ext_vector_type(16)));
typedef short bf16x8 __attribute__((ext_vector_type(8)));
typedef short s16x4 __attribute__((ext_vector_type(4)));
typedef short v4i16_t __attribute__((ext_vector_type(4)));
constexpr int KP = 144, LW_K = 0, LW_V = 4608, LW_F = 8704, LW_BYTES = 9216, LDS_BTAB = 8 * LW_BYTES, BT_PITCH = 132;
#define ATT_FENCE() asm volatile("" ::: "memory")
__device__ __forceinline__ int crow(int r, int h) { return (r & 3) + 8 * (r >> 2) + 4 * h; }
__device__ __forceinline__ s16x4 vtr(const LAS unsigned char* p) { return __builtin_bit_cast(s16x4, __builtin_amdgcn_ds_read_tr16_b64_v4i16((LAS v4i16_t*)p)); }
__device__ __forceinline__ float swap_other(float x, int hh) { auto rr = __builtin_amdgcn_permlane32_swap(__float_as_uint(x), __float_as_uint(x), false, false); return __uint_as_float(hh ? rr[0] : rr[1]); }

struct KVRegs { u32x4 k[4], v[4]; };
__device__ __forceinline__ void kv_issue(KVRegs& R, const bf16* base, int kcol, int vcol, const int (&tok)[4], int lane) {
#pragma unroll
    for (int i = 0; i < 4; ++i) { const bf16* pr = base + (size_t)tok[i] * DIN + (lane & 7) * 8; R.k[i] = *(const u32x4*)(pr + kcol); R.v[i] = *(const u32x4*)(pr + vcol); }
}
__device__ __forceinline__ void kv_write(LAS unsigned char* wl, const KVRegs& R, int lane) {
    const int row = lane >> 3, ch = lane & 7;
    ATT_FENCE();
#pragma unroll
    for (int i = 0; i < 4; ++i) { *(LAS u32x4*)(wl + LW_K + (row + 8 * i) * KP + ch * 16) = R.k[i]; *(LAS u32x4*)(wl + LW_V + (ch >> 2) * 2048 + (row + 8 * i) * 64 + (ch & 3) * 16) = R.v[i]; }
    ATT_FENCE();
}
__device__ __forceinline__ f32x16 qk_tile(const LAS unsigned char* wl, const bf16x8 (&qf)[4], int lane) {
    const LAS unsigned char* kp = wl + LW_K + (lane & 31) * KP + (lane >> 5) * 16;
    f32x16 S = {};
#pragma unroll
    for (int d0 = 0; d0 < 4; ++d0) { const bf16x8 kf = *(const LAS bf16x8*)(kp + d0 * 32); S = __builtin_amdgcn_mfma_f32_32x32x16_bf16(kf, qf[d0], S, 0, 0, 0); }
    return S;
}
__device__ __forceinline__ void pv_tile(const LAS unsigned char* wl, const float (&w)[16], f32x16& o0, f32x16& o1, int lane) {
    const int hh = lane >> 5;
    const LAS unsigned char* vp = wl + LW_V + ((lane >> 4) & 1) * 32 + (lane & 3) * 8 + (4 * hh + ((lane & 15) >> 2)) * 64;
    s16x4 lo[2][2], hi[2][2];
#pragma unroll
    for (int s2 = 0; s2 < 2; ++s2)
#pragma unroll
        for (int dh = 0; dh < 2; ++dh) { lo[s2][dh] = vtr(vp + dh * 2048 + s2 * 1024); hi[s2][dh] = vtr(vp + dh * 2048 + s2 * 1024 + 512); }
#pragma unroll
    for (int s2 = 0; s2 < 2; ++s2) {
        u32x4 pw; pw.x = pk2(w[8 * s2 + 0], w[8 * s2 + 1]); pw.y = pk2(w[8 * s2 + 2], w[8 * s2 + 3]); pw.z = pk2(w[8 * s2 + 4], w[8 * s2 + 5]); pw.w = pk2(w[8 * s2 + 6], w[8 * s2 + 7]);
        const bf16x8 pa = __builtin_bit_cast(bf16x8, pw);
        const bf16x8 v0 = {lo[s2][0][0], lo[s2][0][1], lo[s2][0][2], lo[s2][0][3], hi[s2][0][0], hi[s2][0][1], hi[s2][0][2], hi[s2][0][3]};
        const bf16x8 v1 = {lo[s2][1][0], lo[s2][1][1], lo[s2][1][2], lo[s2][1][3], hi[s2][1][0], hi[s2][1][1], hi[s2][1][2], hi[s2][1][3]};
        o0 = __builtin_amdgcn_mfma_f32_32x32x16_bf16(pa, v0, o0, 0, 0, 0);
        o1 = __builtin_amdgcn_mfma_f32_32x32x16_bf16(pa, v1, o1, 0, 0, 0);
    }
}
__device__ __forceinline__ void store_o(LAS unsigned char* wl, const f32x16& o0, const f32x16& o1, float qscale, bf16* dst, const int (&qtok)[4], int lane) {
    const int r = lane & 31, hh = lane >> 5;
    LAS float* fs = (LAS float*)(wl + LW_F); LAS unsigned short* stg = (LAS unsigned short*)(wl + LW_K);
    ATT_FENCE();
    if (hh == 0) fs[r] = qscale;
    ATT_FENCE();
#pragma unroll
    for (int gi = 0; gi < 4; ++gi) { const f32x4 sc = *(const LAS f32x4*)(fs + 8 * gi + 4 * hh);
#pragma unroll
        for (int e = 0; e < 4; ++e) { const int q = 8 * gi + 4 * hh + e; stg[q * 64 + r] = (unsigned short)f2bf(o0[4 * gi + e] * sc[e]); stg[q * 64 + 32 + r] = (unsigned short)f2bf(o1[4 * gi + e] * sc[e]); } }
    ATT_FENCE();
#pragma unroll
    for (int i = 0; i < 4; ++i) { const int row = (lane >> 3) + 8 * i; const u32x4 v = *(const LAS u32x4*)(stg + row * 64 + (lane & 7) * 8); *(u32x4*)(dst + (size_t)qtok[i] * OC + (lane & 7) * 8) = v; }
    ATT_FENCE();
}

__device__ __forceinline__ void sb_item(const bf16* qkvg, bf16* ocat, int b, int h, int qt, LAS unsigned char* wl, int lane) {
    const int r = lane & 31, hh = lane >> 5; const bf16* base = qkvg + (size_t)b * SEQ * DIN;
    bf16x8 qf[4];
#pragma unroll
    for (int d0 = 0; d0 < 4; ++d0) qf[d0] = *(const bf16x8*)(base + (size_t)(qt * 32 + r) * DIN + C_QSB + h * HD + 16 * d0 + 8 * hh);
    f32x16 o0 = {}, o1 = {}; float carry = 1.0f;
    KVRegs R0, R1;
#define SB_ISSUE(R_, kt_) do { int tok[4]; _Pragma("unroll") for (int i = 0; i < 4; ++i) tok[i] = (kt_) * 32 + (lane >> 3) + 8 * i; kv_issue(R_, base, C_KSB + h * HD, C_VSB + h * HD, tok, lane); } while (0)
    SB_ISSUE(R0, qt); if (qt > 0) SB_ISSUE(R1, qt - 1);
    asm volatile("" :: "v"(qf[0]), "v"(qf[1]), "v"(qf[2]), "v"(qf[3]));
    auto tile = [&](int kt) -> bool {
        const f32x16 S = qk_tile(wl, qf, lane);
        float f[16], be[16];
#pragma unroll
        for (int g = 0; g < 16; ++g) { const float e = __builtin_amdgcn_exp2f(fminf(S[g], 80.f)); const float fr = __builtin_amdgcn_rcpf(1.0f + e); f[g] = fr; be[g] = e * fr; }
        if (kt == qt) {
#pragma unroll
            for (int g = 0; g < 16; ++g) { const bool valid = crow(g, hh) < r; f[g] = valid ? f[g] : 1.0f; be[g] = valid ? be[g] : 0.0f; }
        }
        float X[16], T0[4], T1[4];
#pragma unroll
        for (int gi = 0; gi < 4; ++gi) { const float L3 = f[4 * gi + 3], L2 = f[4 * gi + 2] * L3, L1 = f[4 * gi + 1] * L2, L0 = f[4 * gi] * L1;
            X[4 * gi + 3] = 1.0f; X[4 * gi + 2] = L3; X[4 * gi + 1] = L2; X[4 * gi] = L1;
            auto rr = __builtin_amdgcn_permlane32_swap(__float_as_uint(L0), __float_as_uint(L0), false, false); T0[gi] = __uint_as_float(rr[0]); T1[gi] = __uint_as_float(rr[1]); }
        float E[4]; E[3] = carry; E[2] = E[3] * (T0[3] * T1[3]); E[1] = E[2] * (T0[2] * T1[2]); E[0] = E[1] * (T0[1] * T1[1]); carry = E[0] * (T0[0] * T1[0]);
        float w[16];
#pragma unroll
        for (int g = 0; g < 16; ++g) { const float eg = hh ? E[g >> 2] : E[g >> 2] * T1[g >> 2]; w[g] = be[g] * (eg * X[g]); }
        pv_tile(wl, w, o0, o1, lane);
        return __all(carry < 1.2e-38f) != 0;
    };
    for (int kt = qt; kt >= 0; kt -= 2) {
        kv_write(wl, R0, lane); if (kt > 1) SB_ISSUE(R0, kt - 2);
        if (tile(kt)) break;
        if (kt == 0) break;
        kv_write(wl, R1, lane); if (kt > 2) SB_ISSUE(R1, kt - 3);
        if (tile(kt - 1)) break;
    }
#undef SB_ISSUE
    int qtok[4];
#pragma unroll
    for (int i = 0; i < 4; ++i) qtok[i] = qt * 32 + (lane >> 3) + 8 * i;
    store_o(wl, o0, o1, 1.0f, ocat + (size_t)b * SEQ * OC + h * HD, qtok, lane);
}

struct BandState { float m, l; f32x16 o0, o1; };
__device__ __forceinline__ void band_group(BandState& st, const bf16* base, int qtok, int qcol, int kcol, int vcol, int d, int sstep, int P0, int kres, int NT, int maxd,
                                           const LAS float* bt, LAS unsigned char* wl, int lane) {
    const int r = lane & 31, hh = lane >> 5;
    LAS float* fs = (LAS float*)(wl + LW_F);
    bf16x8 qf[4];
#pragma unroll
    for (int d0 = 0; d0 < 4; ++d0) qf[d0] = *(const bf16x8*)(base + (size_t)qtok * DIN + qcol + 16 * d0 + 8 * hh);
    const int c0 = P0 >= 128 ? 0 : ((128 - P0) >> 5);
    KVRegs R0, R1;
#define BAND_ISSUE(R_, cc) do { int tok[4]; const int ib_ = P0 - 128 + 32 * (cc); _Pragma("unroll") for (int i = 0; i < 4; ++i) { const int ix = ib_ + (lane >> 3) + 8 * i; const int tk = kres + d * (ix < 0 ? 0 : ix); tok[i] = tk > SEQ - 1 ? SEQ - 1 : tk; } \
        kv_issue(R_, base, kcol, vcol, tok, lane); } while (0)
    BAND_ISSUE(R0, c0); if (c0 + 1 < NT) BAND_ISSUE(R1, c0 + 1);
    asm volatile("" :: "v"(qf[0]), "v"(qf[1]), "v"(qf[2]), "v"(qf[3]));
    auto tile = [&](int c) {
        const int idx0 = P0 - 128 + 32 * c;
        const f32x16 S = qk_tile(wl, qf, lane);
        float sc[16]; float mx = -1e30f;
        const int rel0 = sstep * r + 128 - 32 * c - 4 * hh;
#pragma unroll
        for (int g = 0; g < 16; ++g) { const int rel = rel0 - (g & 3) - 8 * (g >> 2); const int ri = (rel < -1 ? -1 : (rel > maxd + 1 ? maxd + 1 : rel)) + 1; sc[g] = S[g] + bt[ri]; }
        if (idx0 < 0) {
#pragma unroll
            for (int g = 0; g < 16; ++g) sc[g] = (idx0 + crow(g, hh) >= 0) ? sc[g] : -1e30f;
        }
#pragma unroll
        for (int g = 0; g < 16; ++g) mx = fmaxf(mx, sc[g]);
        mx = fmaxf(mx, swap_other(mx, hh));
        if (__any(mx > st.m + 8.0f)) {
            const float mn = fmaxf(st.m, mx), fsc = __builtin_amdgcn_exp2f(st.m - mn); st.l *= fsc; st.m = mn;
            ATT_FENCE(); if (hh == 0) fs[r] = fsc; ATT_FENCE();
#pragma unroll
            for (int gi = 0; gi < 4; ++gi) { const f32x4 fv = *(const LAS f32x4*)(fs + 8 * gi + 4 * hh);
#pragma unroll
                for (int e = 0; e < 4; ++e) { st.o0[4 * gi + e] *= fv[e]; st.o1[4 * gi + e] *= fv[e]; } }
            ATT_FENCE();
        }
        float w[16]; float ls = 0.f;
#pragma unroll
        for (int g = 0; g < 16; ++g) { w[g] = __builtin_amdgcn_exp2f(sc[g] - st.m); ls += w[g]; }
        st.l += ls;
        pv_tile(wl, w, st.o0, st.o1, lane);
    };
    for (int c = c0; c < NT; c += 2) {
        kv_write(wl, R0, lane); if (c + 2 < NT) BAND_ISSUE(R0, c + 2);
        tile(c);
        if (c + 1 >= NT) break;
        kv_write(wl, R1, lane); if (c + 3 < NT) BAND_ISSUE(R1, c + 3);
        tile(c + 1);
    }
#undef BAND_ISSUE
}
}

__device__ __forceinline__ void ph_attn(Frame& F, int l) {
    using namespace att;
    LAS float* btab = (LAS float*)(F.lds + LDS_BTAB);
    const float* relb = F.in[I_RELB];
    for (int idx = F.tid; idx < 12 * 131; idx += NTHREADS) { const int head = idx / 131, e = idx % 131; const int dd = head < 2 ? 1 : (head < 4 ? 4 : (head < 6 ? 16 : 1)), maxd = head < 6 ? 128 : 127;
        const int rel = e - 1;
        btab[head * BT_PITCH + e] = (rel < 0 || rel > maxd) ? -1e30f : relb[t5_bucket(rel * dd) * 12 + head] * LOG2E; }
    __syncthreads();
    LAS unsigned char* wl = F.lds + F.wave * LW_BYTES;
    const int lane = F.lane, r = lane & 31, hh = lane >> 5;
    const int half = F.wave >> 1, NH = F.G * (NTHREADS / 128); const int j0 = F.wg * (NTHREADS / 128) + half;
    if ((F.wave & 1) == 0) {
        for (int it = j0; it < 1024; it += NH) {
            const int b = it >> 7, slot = (it >> 6) & 1, r16 = (it >> 2) & 15, i0 = (it & 3) * 32;
            const bf16* base = F.QKVG + (size_t)b * SEQ * DIN; const int qtok = r16 + 16 * (i0 + r);
            BandState st; st.m = -1e20f; st.l = 0.f; st.o0 = f32x16{}; st.o1 = f32x16{};
            band_group(st, base, qtok, C_QDIL + (4 + slot) * HD, C_KDIL + (4 + slot) * HD, C_VDIL + (4 + slot) * HD, 16, 1, i0, r16, 5, 128, btab + (4 + slot) * BT_PITCH, wl, lane);
            band_group(st, base, qtok, C_QDIL + (2 + slot) * HD, C_KDIL + (2 + slot) * HD, C_VDIL + (2 + slot) * HD, 4, 4, (r16 >> 2) + 4 * i0, r16 & 3, 8, 128, btab + (2 + slot) * BT_PITCH, wl, lane);
            band_group(st, base, qtok, C_QDIL + slot * HD, C_KDIL + slot * HD, C_VDIL + slot * HD, 1, 16, r16 + 16 * i0, 0, 20, 128, btab + slot * BT_PITCH, wl, lane);
            const float lt = st.l + swap_other(st.l, hh);
            int qt4[4];
#pragma unroll
            for (int i = 0; i < 4; ++i) qt4[i] = r16 + 16 * (i0 + (lane >> 3) + 8 * i);
            store_o(wl, st.o0, st.o1, 1.0f / lt, F.OCAT + (size_t)b * SEQ * OC + 256 + slot * HD, qt4, lane);
        }
    } else {
        for (int x = j0; x < 2048; x += NH) {
            const int qt = 63 - (x >> 5), b = (x & 31) >> 2, h = x & 3;
            sb_item(F.QKVG, F.OCAT, b, h, qt, wl, lane);
        }
        for (int x = j0; x < 3072; x += NH) {
            const int hq = x % 6, qt = (x / 6) % 64, b = x / 384, kv = hq / 3;
            const bf16* base = F.QKVG + (size_t)b * SEQ * DIN;
            const float sk = F.in[I_SINKS][l * 6 + hq] * LOG2E;
            BandState st; st.m = sk; st.l = 0.f; st.o0 = f32x16{}; st.o1 = f32x16{};
            band_group(st, base, qt * 32 + r, C_QSWA + hq * HD, C_KSWA + kv * HD, C_VSWA + kv * HD, 1, 1, qt * 32, 0, 5, 127, btab + (6 + hq) * BT_PITCH, wl, lane);
            const float lt = st.l + swap_other(st.l, hh) + __builtin_amdgcn_exp2f(sk - st.m);
            int qt4[4];
#pragma unroll
            for (int i = 0; i < 4; ++i) qt4[i] = qt * 32 + (lane >> 3) + 8 * i;
            store_o(wl, st.o0, st.o1, 1.0f / lt, F.OCAT + (size_t)b * SEQ * OC + 384 + hq * HD, qt4, lane);
        }
    }
}

#define XB_TMO      128
#define XB_XCNT(j)  (256  + 64 * (j))
#define XB_XSUB(j)  (1280 + 64 * (j))
#define XB_XGEN(j)  (2304 + 64 * (j))
#define XB_TOP      3328
#define XB_TOPGEN   3392
#define XCD_BAR_WORDS 3456
#define XB_SPIN_CAP (1u << 18)
__device__ __forceinline__ unsigned xb_ld(unsigned* p)              { return __hip_atomic_load(p, __ATOMIC_RELAXED, __HIP_MEMORY_SCOPE_AGENT); }
__device__ __forceinline__ unsigned xb_add(unsigned* p, unsigned v) { return __hip_atomic_fetch_add(p, v, __ATOMIC_RELAXED, __HIP_MEMORY_SCOPE_AGENT); }
__device__ __forceinline__ unsigned xb_xcc_id() { return (unsigned)__builtin_amdgcn_s_getreg((3 << 11) | 20) & 0xFu; }
#define XB_SPIN(cond, bar) do { unsigned _sp = 0; while (cond) { __builtin_amdgcn_s_sleep(1); \
    if ((++_sp & 255u) == 0u) { if (xb_ld(&(bar)[XB_TMO])) break; if (_sp > XB_SPIN_CAP) { atomicAdd(&(bar)[XB_TMO], 1u); break; } } } } while (0)
struct XcdBarrier { unsigned* bar; unsigned x; volatile LAS unsigned* st; };
__device__ __forceinline__ XcdBarrier xcd_barrier_post(unsigned* bar, volatile LAS unsigned* st) {
    XcdBarrier b; b.bar = bar; b.x = xb_xcc_id(); b.st = st;
    if (threadIdx.x == 0) (void)xb_add(&bar[XB_XCNT(b.x)], 1u);
    return b;
}
__device__ __forceinline__ void xcd_barrier_complete(unsigned* bar, unsigned x, unsigned& nloc, unsigned& nx) {
    const unsigned G = gridDim.x * gridDim.y * gridDim.z;
    unsigned sum, cnt, mine, sp = 0u;
    for (;;) {
        sum = 0u; cnt = 0u; mine = 0u;
#pragma unroll
        for (unsigned j = 0; j < 16; ++j) { const unsigned c = xb_ld(&bar[XB_XCNT(j)]); sum += c; cnt += (c > 0u) ? 1u : 0u; mine = (j == x) ? c : mine; }
        if (sum == G) break;
        __builtin_amdgcn_s_sleep(1);
        if ((++sp & 255u) == 0u) { if (xb_ld(&bar[XB_TMO])) break; if (sp > XB_SPIN_CAP) { atomicAdd(&bar[XB_TMO], 1u); break; } }
    }
    nloc = mine > 0u ? mine : 1u; nx = cnt > 0u ? cnt : 1u;
}
__device__ __forceinline__ void xcd_barrier(const XcdBarrier& b) {
    asm volatile("s_waitcnt vmcnt(0)" ::: "memory");
    __syncthreads();
    if (threadIdx.x == 0) {
        unsigned* bar = b.bar;
        __builtin_amdgcn_s_waitcnt(0);
        unsigned nloc = b.st[0], nx = b.st[1];
        if (nloc == 0u) { xcd_barrier_complete(bar, b.x, nloc, nx); b.st[0] = nloc; b.st[1] = nx; }
        const unsigned old = xb_add(&bar[XB_XSUB(b.x)], 1u);
        const unsigned gen = old / nloc;
        if (old + 1u == (gen + 1u) * nloc) {
            __builtin_amdgcn_fence(__ATOMIC_RELEASE, "agent");
            asm volatile("s_waitcnt vmcnt(0)" ::: "memory");
            const unsigned og = xb_add(&bar[XB_TOP], 1u);
            const unsigned tg = og / nx;
            if (og + 1u == (tg + 1u) * nx) xb_add(&bar[XB_TOPGEN], 1u);
            else XB_SPIN(xb_ld(&bar[XB_TOPGEN]) == tg, bar);
            __builtin_amdgcn_fence(__ATOMIC_ACQUIRE, "agent");
            xb_add(&bar[XB_XGEN(b.x)], 1u);
            asm volatile("s_waitcnt vmcnt(0)" ::: "memory");
        } else {
            XB_SPIN(xb_ld(&bar[XB_XGEN(b.x)]) == gen, bar);
            __builtin_amdgcn_fence(__ATOMIC_ACQUIRE, "agent");
            asm volatile("s_waitcnt vmcnt(0)" ::: "memory");
        }
    }
    __syncthreads();
}

#ifndef MK_ONE_LAUNCH
#define MK_ONE_LAUNCH 1
#endif
constexpr int NPHASE = 20;
constexpr int RING_BYTES = 131072, MISC_OFF = RING_BYTES + 320, LDS_BYTES = 147456;
static_assert(XCD_BAR_WORDS * 4 <= (int)WS_MOD && att::LDS_BTAB + 12 * att::BT_PITCH * 4 <= RING_BYTES, "maps");

__global__ void __launch_bounds__(NTHREADS, 2) mk_fwd(Args a) {
    extern __shared__ __attribute__((aligned(16))) unsigned char lds[];
    Frame F;
    F.lds = (LAS unsigned char*)lds; F.tid = threadIdx.x; F.lane = F.tid & 63; F.wave = __builtin_amdgcn_readfirstlane(F.tid >> 6); F.G = gridDim.x; F.wg = blockIdx.x;
#pragma unroll
    for (int i = 0; i < 16; ++i) F.in[i] = a.in[i];
    F.X = a.out; F.ws = a.ws; F.mod = (float*)(a.ws + WS_MOD); F.SS = (float*)(a.ws + WS_SS); F.SW = (float*)(a.ws + WS_SW); F.H = (bf16*)(a.ws + WS_H); F.H2 = (bf16*)(a.ws + WS_H2); F.OCAT = (bf16*)(a.ws + WS_OCAT); F.QKVG = (bf16*)(a.ws + WS_BIG); F.ACT = (bf16*)(a.ws + WS_BIG);
    volatile LAS unsigned* MISC = (volatile LAS unsigned*)(F.lds + MISC_OFF);
    if (F.tid < 32) MISC[F.tid] = 0u;
    __syncthreads();
    const int lo = a.ph_lo, hi = a.ph_hi;
    XcdBarrier bar; bar.bar = (unsigned*)(a.ws + WS_CTL); bar.x = 0; bar.st = nullptr;
    if (hi - lo > 1) bar = xcd_barrier_post((unsigned*)(a.ws + WS_CTL), MISC + 8);
    unsigned char* const wb = a.ws + WS_W;
#define PHASE(k, ...) do { if (lo <= (k) && (k) < hi) { __VA_ARGS__; if ((k) + 1 < hi) xcd_barrier(bar); } } while (0)
#define LAYER(l, XIN0, P) \
    PHASE((P) + 0, ph_ffn_up(F, F.H, (const bf16*)(wb + WO_GU0), (l), 0)); \
    PHASE((P) + 1, ph_xupd<true, true>(F, F.ACT, DFF, (const bf16*)(wb + WO_D0), (XIN0), F.X, F.H, (l), 0, (l), 1)); \
    PHASE((P) + 2, ph_inproj(F, (l))); \
    PHASE((P) + 3, ph_attn(F, (l))); \
    PHASE((P) + 4, ph_branch(F)); \
    PHASE((P) + 5, ph_xupd<true, false>(F, F.H, D, (const bf16*)(wb + WO_OUT), F.X, F.X, F.H2, (l), 1, (l), 2)); \
    PHASE((P) + 6, ph_ffn_up(F, F.H2, (const bf16*)(wb + WO_GU1), (l), 2)); \
    PHASE((P) + 7, ph_xupd<((l) + 1 < DEPTH), true>(F, F.ACT, DFF, (const bf16*)(wb + WO_D1), F.X, F.X, F.H, (l), 2, (l) + 1, 0))
    PHASE(0, ph_adaln(F));
    PHASE(1, ph_convert(F, 0); ph_prep0(F));
    LAYER(0, F.in[I_X], 2);
    PHASE(10, ph_convert(F, 1));
    LAYER(1, F.X, 11);
    PHASE(NPHASE - 1, ph_final(F));
#undef LAYER
#undef PHASE
}

extern "C" void kernel_launch(void* const* d_in, const int* in_sizes, int n_in, void* d_out, int out_size, void* d_ws, size_t ws_size, hipStream_t stream) {
    static int grid = 0;
    if (grid == 0) {
        if (n_in != 16 || in_sizes[0] != M * D || out_size != M * D || ws_size < WS_END) { fprintf(stderr, "kernel_launch: unexpected shapes (n_in %d, in0 %d, out %d, ws %zu)\n", n_in, n_in > 0 ? in_sizes[0] : -1, out_size, ws_size); grid = -1; return; }
        int dev = 0, cus = 0, per_cu = 0;
        if (hipGetDevice(&dev) != hipSuccess || hipDeviceGetAttribute(&cus, hipDeviceAttributeMultiprocessorCount, dev) != hipSuccess) { grid = -1; return; }
        if (hipFuncSetAttribute((const void*)mk_fwd, hipFuncAttributeMaxDynamicSharedMemorySize, LDS_BYTES) != hipSuccess) { fprintf(stderr, "kernel_launch: hipFuncSetAttribute failed\n"); grid = -1; return; }
        if (hipOccupancyMaxActiveBlocksPerMultiprocessor(&per_cu, (const void*)mk_fwd, NTHREADS, LDS_BYTES) != hipSuccess || per_cu < 1) { fprintf(stderr, "kernel_launch: occupancy query reports %d workgroups per CU\n", per_cu); (void)hipGetLastError(); grid = -1; return; }
        grid = cus;
    }
    if (grid < 0) return;
    Args a{};
    for (int i = 0; i < 16; ++i) a.in[i] = (const float*)d_in[i];
    a.out = (float*)d_out; a.ws = (unsigned char*)d_ws;
#if MK_ONE_LAUNCH
    (void)hipMemsetAsync((char*)d_ws + WS_CTL, 0, ZERO_BYTES, stream);
    a.ph_lo = 0; a.ph_hi = NPHASE;
    hipLaunchKernelGGL(mk_fwd, dim3(grid), dim3(NTHREADS), LDS_BYTES, stream, a);
#else
    for (int ph = 0; ph < NPHASE; ++ph) { a.ph_lo = ph; a.ph_hi = ph + 1; hipLaunchKernelGGL(mk_fwd, dim3(grid), dim3(NTHREADS), LDS_BYTES, stream, a); }
#endif
}
```
